# Optimizing an MI355X kernel written in HIP

```python
import jax
import jax.numpy as jnp
from jax import lax
import numpy as np

D_MODEL = 2048
BATCH = 1
SEQ = 16384
DEPTH = 2

GRID_W = 64
CTX_LEN = 256
NORM_EPS = 1e-6
N_ADA = 6
D_LRU = D_MODEL // 2
LRU_HEADS = D_LRU // 128
LRU_BW = D_LRU // LRU_HEADS
CONV_W = 4
CONV_LEFT = 2
RGLRU_C = 8.0
D_POOL = D_MODEL // 4
POOL_WINDOWS = (2, 4, 8, 16)
N_POOL_GROUPS = len(POOL_WINDOWS)
POOL_GC = D_POOL // N_POOL_GROUPS
POOL_OUT_GC = D_MODEL // N_POOL_GROUPS
D_FOURIER = D_MODEL // 4
FOURIER_GROUPS = 4
FOURIER_GC = D_FOURIER // FOURIER_GROUPS
N_BRANCHES = 3
I_YA = D_LRU
I_XB = 2 * D_LRU
I_XC = I_XB + D_POOL
I_G = I_XC + D_FOURIER
D_IN = I_G + N_BRANCHES * D_MODEL
D_FF = ((8 * D_MODEL + 3 * 256 - 1) // (3 * 256)) * 256

kernel_name = "hybrid_gated_lru_pool_fourier_dit"


def _rms_norm(x, g):
    xf = x.astype(jnp.float32)
    y = xf * lax.rsqrt(jnp.mean(xf * xf, axis=-1, keepdims=True) + NORM_EPS)
    return (y * g.astype(jnp.float32)).astype(x.dtype)


def _modulate(h, shift, scale):
    return h * (1 + scale) + shift


def _centred_depthwise_conv(x, w, b):
    y = lax.conv_general_dilated(
        x, w[:, None, :].astype(x.dtype), window_strides=(1,),
        padding=[(CONV_LEFT, CONV_W - 1 - CONV_LEFT)],
        dimension_numbers=('NWC', 'WIO', 'NWC'), feature_group_count=x.shape[-1])
    return y + b


def _lin_combine(left, right):
    a1, b1 = left
    a2, b2 = right
    return a1 * a2, a2 * b1 + b2


def _rglru_scan(xc, wa, ba, wx, bx, lam, h0, reverse):
    B, L, _ = xc.shape
    f32 = jnp.float32
    xf = xc.astype(f32)
    xh = xf.reshape(B, L, LRU_HEADS, LRU_BW)
    r = jax.nn.sigmoid(jnp.einsum('blhi,hij->blhj', xh, wa.astype(f32)) + ba.astype(f32)).reshape(B, L, D_LRU)
    i = jax.nn.sigmoid(jnp.einsum('blhi,hij->blhj', xh, wx.astype(f32)) + bx.astype(f32)).reshape(B, L, D_LRU)
    log_a = -RGLRU_C * r * jax.nn.softplus(-lam.astype(f32))
    a = jnp.exp(log_a)
    b = jnp.sqrt(-jnp.expm1(2.0 * log_a)) * (i * xf)
    a_cum, h = lax.associative_scan(_lin_combine, (a, b), axis=1, reverse=reverse)
    return h + a_cum * h0.astype(f32)[:, None, :]


def _bidir_rglru(xa, conv_w, conv_b, lru_wa, lru_ba, lru_wx, lru_bx, lru_lambda, h0_f, h0_b):
    xconv = _centred_depthwise_conv(xa, conv_w, conv_b)
    h_f = _rglru_scan(xconv, lru_wa[0], lru_ba[0], lru_wx[0], lru_bx[0], lru_lambda[0], h0_f, False)
    h_b = _rglru_scan(xconv, lru_wa[1], lru_ba[1], lru_wx[1], lru_bx[1], lru_lambda[1], h0_b, True)
    return h_f, h_b


def _multiscale_pool(xb, rows, w_pool, pool_scale):
    B, L, _ = xb.shape
    width = L // rows
    xg = xb.astype(jnp.float32).reshape(B, rows, width, N_POOL_GROUPS, POOL_GC)
    cs = jnp.pad(jnp.cumsum(xg, axis=2), ((0, 0), (0, 0), (1, 0), (0, 0), (0, 0)))
    t = jnp.arange(width)[:, None]
    win = jnp.array(POOL_WINDOWS, jnp.int32)[None, :]
    lo = jnp.clip(t - win // 2, 0, width)
    hi = jnp.clip(t - win // 2 + win, 0, width)
    grp = jnp.arange(N_POOL_GROUPS)[None, :]
    window_sum = cs[:, :, hi, grp] - cs[:, :, lo, grp]
    mean = window_sum / (hi - lo).astype(jnp.float32)[:, :, None]
    pooled = (mean - xg).reshape(B, L, N_POOL_GROUPS, POOL_GC).astype(xb.dtype)
    y = jnp.einsum('blgi,gio->blgo', pooled, w_pool).reshape(B, L, D_MODEL)
    return y * pool_scale


def _fourier_mix(xc, w_fourier):
    B, L, _ = xc.shape
    xg = xc.astype(jnp.float32).reshape(B, L, FOURIER_GROUPS, FOURIER_GC)
    f = jnp.fft.fft2(xg, axes=(1, 3), norm='ortho').real
    return f.reshape(B, L, D_FOURIER).astype(xc.dtype) @ w_fourier


def _mixer(u, rows, h0_f, h0_b, w_in, conv_w, conv_b, lru_wa, lru_ba, lru_wx, lru_bx, lru_lambda,
           w_lru_out, w_pool, pool_scale, w_fourier, b_gate, w_out):
    xa, ya, xb, xc, gl = jnp.split(u @ w_in, [I_YA, I_XB, I_XC, I_G], axis=-1)
    h_f, h_b = _bidir_rglru(xa, conv_w, conv_b, lru_wa, lru_ba, lru_wx, lru_bx, lru_lambda, h0_f, h0_b)
    lru_out = ((h_f + h_b).astype(u.dtype) * jax.nn.gelu(ya)) @ w_lru_out
    pool_out = _multiscale_pool(xb, rows, w_pool, pool_scale)
    four_out = _fourier_mix(xc, w_fourier)
    g_lru, g_pool, g_four = jnp.split(jax.nn.sigmoid(gl + b_gate), N_BRANCHES, axis=-1)
    merged = g_lru * lru_out + g_pool * pool_out + g_four * four_out
    return merged @ w_out, h_f, h_b


def _swiglu(u, w_ffn_in, w_ffn_out):
    gate, up = jnp.split(u @ w_ffn_in, 2, axis=-1)
    return (jax.nn.silu(gate) * up) @ w_ffn_out


def setup_inputs(seed: int = 0) -> dict:
    key = jax.random.key(seed)
    ks = jax.random.split(key, 26)
    f32 = jnp.float32

    def nrm(k, shape, scale):
        return jax.random.normal(k, shape, f32) * scale

    a_init = jax.random.uniform(ks[15], (DEPTH, 2, D_LRU), f32, 0.9, 0.999) ** (1.0 / RGLRU_C)
    return {
        'x': nrm(ks[0], (BATCH, SEQ, D_MODEL), 1.0),
        'c': nrm(ks[1], (BATCH, D_MODEL), 1.0),
        'ctx': nrm(ks[2], (BATCH, CTX_LEN, D_MODEL), 1.0),
        'c_ctx': nrm(ks[3], (D_MODEL,), 1.0),
        'w_ada': nrm(ks[4], (DEPTH, D_MODEL, N_ADA * D_MODEL), 0.5 * D_MODEL ** -0.5),
        'b_ada': nrm(ks[5], (DEPTH, N_ADA * D_MODEL), 0.1),
        'norm1_g': 1.0 + nrm(ks[6], (DEPTH, D_MODEL), 0.05),
        'norm2_g': 1.0 + nrm(ks[7], (DEPTH, D_MODEL), 0.05),
        'w_in': nrm(ks[8], (DEPTH, D_MODEL, D_IN), D_MODEL ** -0.5),
        'conv_w': nrm(ks[9], (DEPTH, CONV_W, D_LRU), CONV_W ** -0.5),
        'conv_b': nrm(ks[10], (DEPTH, D_LRU), 0.02),
        'lru_wa': nrm(ks[11], (DEPTH, 2, LRU_HEADS, LRU_BW, LRU_BW), LRU_BW ** -0.5),
        'lru_ba': nrm(ks[12], (DEPTH, 2, LRU_HEADS, LRU_BW), 0.02),
        'lru_wx': nrm(ks[13], (DEPTH, 2, LRU_HEADS, LRU_BW, LRU_BW), LRU_BW ** -0.5),
        'lru_bx': nrm(ks[14], (DEPTH, 2, LRU_HEADS, LRU_BW), 0.02),
        'lru_lambda': jnp.log(a_init) - jnp.log1p(-a_init),
        'w_lru_out': nrm(ks[16], (DEPTH, D_LRU, D_MODEL), D_LRU ** -0.5),
        'w_pool': nrm(ks[17], (DEPTH, N_POOL_GROUPS, POOL_GC, POOL_OUT_GC), POOL_GC ** -0.5),
        'pool_scale': 1.0 + nrm(ks[18], (DEPTH, D_MODEL), 0.05),
        'w_fourier': nrm(ks[19], (DEPTH, D_FOURIER, D_MODEL), D_FOURIER ** -0.5),
        'b_gate': nrm(ks[20], (DEPTH, N_BRANCHES * D_MODEL), 0.02),
        'w_out': nrm(ks[21], (DEPTH, D_MODEL, D_MODEL), D_MODEL ** -0.5),
        'w_ffn_in': nrm(ks[22], (DEPTH, D_MODEL, 2 * D_FF), D_MODEL ** -0.5),
        'w_ffn_out': nrm(ks[23], (DEPTH, D_FF, D_MODEL), D_FF ** -0.5),
        'norm_f_g': 1.0 + nrm(ks[24], (D_MODEL,), 0.05),
    }


def reference(x, c, ctx, c_ctx, w_ada, b_ada, norm1_g, norm2_g, w_in, conv_w, conv_b,
              lru_wa, lru_ba, lru_wx, lru_bx, lru_lambda, w_lru_out, w_pool, pool_scale,
              w_fourier, b_gate, w_out, w_ffn_in, w_ffn_out, norm_f_g):
    rows = x.shape[1] // GRID_W
    silu_c = jax.nn.silu(c)
    silu_cc = jax.nn.silu(c_ctx)
    h_zero = jnp.zeros((ctx.shape[0], D_LRU), jnp.float32)
    for l in range(DEPTH):
        last = l == DEPTH - 1
        mod = silu_c @ w_ada[l] + b_ada[l]
        mod_ctx = silu_cc @ w_ada[l] + b_ada[l]
        sh1, sc1, g1, sh2, sc2, g2 = jnp.split(mod[:, None, :], N_ADA, axis=-1)
        sh1c, sc1c, g1c, sh2c, sc2c, g2c = jnp.split(mod_ctx, N_ADA, axis=-1)
        lru_p = (conv_w[l], conv_b[l], lru_wa[l], lru_ba[l], lru_wx[l], lru_bx[l], lru_lambda[l])
        u_ctx = _modulate(_rms_norm(ctx, norm1_g[l]), sh1c, sc1c)
        if last:
            hc_f, hc_b = _bidir_rglru(u_ctx @ w_in[l][:, :D_LRU], *lru_p, h_zero, h_zero)
        else:
            mix_ctx, hc_f, hc_b = _mixer(u_ctx, 1, h_zero, h_zero, w_in[l], *lru_p, w_lru_out[l],
                                         w_pool[l], pool_scale[l], w_fourier[l], b_gate[l], w_out[l])
        h0_f = hc_f[:, -1]
        h0_b = hc_b[:, 0]
        u = _modulate(_rms_norm(x, norm1_g[l]), sh1, sc1)
        mix, _, _ = _mixer(u, rows, h0_f, h0_b, w_in[l], *lru_p, w_lru_out[l],
                           w_pool[l], pool_scale[l], w_fourier[l], b_gate[l], w_out[l])
        x = x + g1 * mix
        x = x + g2 * _swiglu(_modulate(_rms_norm(x, norm2_g[l]), sh2, sc2), w_ffn_in[l], w_ffn_out[l])
        if not last:
            ctx = ctx + g1c * mix_ctx
            ctx = ctx + g2c * _swiglu(_modulate(_rms_norm(ctx, norm2_g[l]), sh2c, sc2c),
                                      w_ffn_in[l], w_ffn_out[l])
    return _rms_norm(x, norm_f_g)
```

```cpp
#include <hip/hip_runtime.h>
#include <hip/hip_cooperative_groups.h>
#include <cstdio>
#include <cstdint>
namespace cg = cooperative_groups;

#ifndef N_LAUNCH_MODE
#define N_LAUNCH_MODE 1
#endif

#define LAS __attribute__((address_space(3)))
typedef unsigned short bf16;
typedef short bf16x8 __attribute__((ext_vector_type(8)));
typedef float f32x4 __attribute__((ext_vector_type(4)));
typedef float f32x2 __attribute__((ext_vector_type(2)));
typedef unsigned u32x4 __attribute__((ext_vector_type(4)));
typedef unsigned u32x2 __attribute__((ext_vector_type(2)));

constexpr int D = 2048, L = 16384, LC = 256, MT = L + LC;
constexpr int DIN = 9216, DFF = 5632, DLRU = 1024, DP = 512, DFO = 512;
constexpr int PP = 3072;
constexpr int I_YA = 1024, I_XB = 2048, I_XC = 2560, I_G = 3072;
constexpr int NCH = MT / 64;
constexpr float NORM_EPS = 1e-6f;
constexpr int NTHREADS = 512, NWAVES = 8;
constexpr int LDS_BYTES = 147456;

constexpr size_t KiB = 1024, MiB = 1024 * 1024;
constexpr size_t OFF_MODS = 0;
constexpr size_t OFF_DCH = 256 * KiB;
constexpr size_t OFF_DA = 320 * KiB;
constexpr size_t OFF_DC = 448 * KiB;
constexpr size_t OFF_E = 1 * MiB;
constexpr size_t OFF_XC = 10 * MiB;
constexpr size_t OFF_AGG = 12 * MiB;
constexpr size_t OFF_YC = 17 * MiB;
constexpr size_t OFF_BAR = 17 * MiB + 512 * KiB;
constexpr size_t BAR_BYTES = 16 * KiB;
constexpr size_t OFF_CARRY = 18 * MiB;
constexpr size_t OFF_W = 21 * MiB;
constexpr size_t W_IN = 0, W_LO = W_IN + (size_t)DIN * D * 2, W_POOL = W_LO + (size_t)D * DLRU * 2, W_F = W_POOL + (size_t)D * 128 * 2,
                 W_OUT = W_F + (size_t)D * DFO * 2, W_FFI = W_OUT + (size_t)D * D * 2, W_FFO = W_FFI + (size_t)2 * DFF * D * 2,
                 W_G = W_FFO + (size_t)D * DFF * 2, W_LAYER = 118 * MiB;
static_assert(W_G + 32 * 16384 * 2 <= W_LAYER, "weights");
constexpr size_t OFF_UB = OFF_W + 2 * W_LAYER;
constexpr size_t OFF_P = OFF_UB + 65 * MiB;
constexpr size_t OFF_GT = OFF_P + 98 * MiB;
constexpr size_t OFF_ALRU = OFF_P + 293 * MiB;
constexpr size_t OFF_PL = OFF_ALRU + 33 * MiB;
constexpr size_t OFF_YT2 = OFF_PL + 17 * MiB;
constexpr size_t OFF_ZT = OFF_YT2 + 32 * MiB;
constexpr size_t OFF_FO = OFF_ZT + 32 * MiB;
constexpr size_t OFF_PART = OFF_FO + 17 * MiB;
constexpr size_t WS_END = OFF_PART + 22 * MiB;
static_assert((size_t)MT * D * 2 <= 65 * MiB && (size_t)MT * PP * 2 <= 98 * MiB && (size_t)MT * 6144 * 2 <= 195 * MiB && (size_t)MT * DFF * 2 <= 293 * MiB && (size_t)MT * 1024 * 2 <= 33 * MiB && (size_t)MT * 512 * 2 <= 17 * MiB, "map");

__device__ __forceinline__ unsigned f2bf(float f) { unsigned u = __builtin_bit_cast(unsigned, f); return (u + 0x7fffu + ((u >> 16) & 1u)) >> 16; }
__device__ __forceinline__ unsigned pk2(float lo, float hi) { return f2bf(lo) | (f2bf(hi) << 16); }
__device__ __forceinline__ float bf2f(unsigned short b) { return __builtin_bit_cast(float, (unsigned)b << 16); }
__device__ __forceinline__ float bflo(unsigned w) { return __builtin_bit_cast(float, w << 16); }
__device__ __forceinline__ float bfhi(unsigned w) { return __builtin_bit_cast(float, w & 0xffff0000u); }
__device__ __forceinline__ float sigmoidf_(float z) { return __builtin_amdgcn_rcpf(1.0f + __builtin_amdgcn_exp2f(-1.4426950408889634f * z)); }
__device__ __forceinline__ float fsigmoid(float z) { return __builtin_amdgcn_rcpf(1.0f + __builtin_amdgcn_exp2f(-1.4426950408889634f * z)); }
__device__ __forceinline__ float softplus_neg(float lam) {
    if (-lam > 20.f) return -lam;
    const float x = __expf(-lam);
    return x < 0.05f ? x * (1.0f - x * (0.5f - x * (0.33333334f - x * (0.25f - x * 0.2f)))) : __logf(1.0f + x);
}
__device__ __forceinline__ float siluf_(float z) { return z * sigmoidf_(z); }
__device__ __forceinline__ float gelu_tanh(float v) { const float u = 1.5957691216f * (v + 0.044715f * v * v * v); return v * sigmoidf_(u); }
__device__ __forceinline__ float wave_sum(float v, int lane) {
#pragma unroll
    for (int o = 1; o < 64; o <<= 1) v += __builtin_bit_cast(float, __builtin_amdgcn_ds_bpermute((lane ^ o) << 2, __builtin_bit_cast(int, v)));
    return v;
}


#define XB_TMO      128
#define XB_XCNT(j)  (256  + 64 * (j))
#define XB_XSUB(j)  (1280 + 64 * (j))
#define XB_XGEN(j)  (2304 + 64 * (j))
#define XB_TOP      3328
#define XB_TOPGEN   3392
#define XCD_BAR_WORDS 3456
#define XB_SPIN_CAP (1u << 18)
__device__ __forceinline__ unsigned xb_ld(unsigned* p)              { return __hip_atomic_load(p, __ATOMIC_RELAXED, __HIP_MEMORY_SCOPE_AGENT); }
__device__ __forceinline__ unsigned xb_add(unsigned* p, unsigned v) { return __hip_atomic_fetch_add(p, v, __ATOMIC_RELAXED, __HIP_MEMORY_SCOPE_AGENT); }
__device__ __forceinline__ unsigned xb_xcc_id() { return (unsigned)__builtin_amdgcn_s_getreg((3 << 11) | 20) & 0xFu; }
#define XB_SPIN(cond, bar) do { unsigned _sp = 0; while (cond) { __builtin_amdgcn_s_sleep(1); \
    if ((++_sp & 255u) == 0u) { if (xb_ld(&(bar)[XB_TMO])) break; if (_sp > XB_SPIN_CAP) { atomicAdd(&(bar)[XB_TMO], 1u); break; } } } } while (0)
struct XcdBarrier { unsigned* bar; unsigned x; volatile LAS unsigned* st; };
__device__ __forceinline__ XcdBarrier xcd_barrier_post(unsigned* bar, volatile LAS unsigned* st) {
    XcdBarrier b; b.bar = bar; b.x = xb_xcc_id(); b.st = st;
    if (threadIdx.x == 0) (void)xb_add(&bar[XB_XCNT(b.x)], 1u);
    return b;
}
__device__ __forceinline__ void xcd_barrier_complete(unsigned* bar, unsigned x, unsigned& nloc, unsigned& nx) {
    const unsigned G = gridDim.x * gridDim.y * gridDim.z;
    unsigned sum, cnt, mine, sp = 0u;
    for (;;) {
        sum = 0u; cnt = 0u; mine = 0u;
#pragma unroll
        for (unsigned j = 0; j < 16; ++j) { const unsigned c = xb_ld(&bar[XB_XCNT(j)]); sum += c; cnt += (c > 0u) ? 1u : 0u; mine = (j == x) ? c : mine; }
        if (sum == G) break;
        __builtin_amdgcn_s_sleep(1);
        if ((++sp & 255u) == 0u) { if (xb_ld(&bar[XB_TMO])) break; if (sp > XB_SPIN_CAP) { atomicAdd(&bar[XB_TMO], 1u); break; } }
    }
    nloc = mine > 0u ? mine : 1u; nx = cnt > 0u ? cnt : 1u;
}
__device__ __forceinline__ void xcd_barrier(const XcdBarrier& b) {
    asm volatile("s_waitcnt vmcnt(0)" ::: "memory");
    __syncthreads();
    if (threadIdx.x == 0) {
        unsigned* bar = b.bar;
        __builtin_amdgcn_s_waitcnt(0);
        unsigned nloc = b.st[0], nx = b.st[1];
        if (nloc == 0u) { xcd_barrier_complete(bar, b.x, nloc, nx); b.st[0] = nloc; b.st[1] = nx; }
        const unsigned old = xb_add(&bar[XB_XSUB(b.x)], 1u);
        const unsigned gen = old / nloc;
        if (old + 1u == (gen + 1u) * nloc) {
            __builtin_amdgcn_fence(__ATOMIC_RELEASE, "agent");
            asm volatile("s_waitcnt vmcnt(0)" ::: "memory");
            const unsigned og = xb_add(&bar[XB_TOP], 1u);
            const unsigned tg = og / nx;
            if (og + 1u == (tg + 1u) * nx) xb_add(&bar[XB_TOPGEN], 1u);
            else XB_SPIN(xb_ld(&bar[XB_TOPGEN]) == tg, bar);
            __builtin_amdgcn_fence(__ATOMIC_ACQUIRE, "agent");
            xb_add(&bar[XB_XGEN(b.x)], 1u);
            asm volatile("s_waitcnt vmcnt(0)" ::: "memory");
        } else {
            XB_SPIN(xb_ld(&bar[XB_XGEN(b.x)]) == gen, bar);
            __builtin_amdgcn_fence(__ATOMIC_ACQUIRE, "agent");
            asm volatile("s_waitcnt vmcnt(0)" ::: "memory");
        }
    }
    __syncthreads();
}

#ifndef PG8_ALIGN_EPI
#define PG8_ALIGN_EPI 1
#endif
namespace pg8 {
#define PG8_LAS __attribute__((address_space(3)))
constexpr int BM = 256, BK = 64, HALF = 128, HTB = HALF * BK * 2, STAGE_BYTES = 8 * HTB, NXCD = 8, WGM = 8;
__host__ __device__ __forceinline__ int lds_byte(int r, int c) { const int st = (r >> 4) * 2 + (c >> 5), rr = r & 15, cc = c & 31, ob = rr * 64 + cc * 2; return st * 1024 + (ob ^ (((ob >> 9) & 1) << 5)); }
__host__ __device__ __forceinline__ void stage_rc(int b, int& R, int& C) { const int st = b / 1024, sb = b % 1024, swz = sb ^ (((sb >> 9) & 1) << 5); R = (st >> 1) * 16 + swz / 64; C = (st & 1) * 32 + (swz % 64) / 2; }
__host__ __device__ __forceinline__ int perm32(int rho) { const int n = rho >> 4, i = rho & 15; return 8 * (i >> 2) + 4 * n + (i & 3); }

struct Unit { const char* A0; const char* A1; const char* B0; const char* B1; unsigned pitchA, pitchB; int nt; int pm, pn, aux; };

struct TileOrder {
    int nM, nN, nwg, G, c, WGMv;
    __device__ void init(int nM_, int nN_, int G_, int c_, int wgm_) { nM = nM_; nN = nN_; nwg = nM * nN; G = G_; c = c_; WGMv = wgm_; }
    __device__ bool get(int i, int& pm, int& pn) const {
        const long Lq = (long)i * G + c; if (Lq >= nwg) return false;
        int wgid = (int)Lq; { const int q = nwg / NXCD, r = nwg % NXCD, xcd = wgid % NXCD, off = wgid / NXCD; wgid = (xcd < r ? xcd * (q + 1) : r * (q + 1) + (xcd - r) * q) + off; }
        const int nig = WGMv * nN, gid = wgid / nig, fm = gid * WGMv, gsz = (nM - fm) < WGMv ? (nM - fm) : WGMv;
        pm = fm + ((wgid % nig) % gsz); pn = (wgid % nig) / gsz; return true;
    }
};

template <class Epi, class Sched>
__device__ __forceinline__ void gemm_phase(PG8_LAS unsigned char* lds, const Sched& S, const Epi& E) {
    int tid_ = threadIdx.x; asm volatile("" : "+v"(tid_)); const int tid = tid_, wid = __builtin_amdgcn_readfirstlane(tid >> 6), lane = tid & 63, wr = wid >> 2, wc = wid & 3, fr = lane & 15, fq = lane >> 4;
    unsigned rA0, rB0, cO0;
    { int R, C; stage_rc(tid * 16, R, C); rA0 = (unsigned)R; rB0 = (unsigned)(Epi::PERM ? ((R & ~31) + perm32(R & 31)) : R); cO0 = (unsigned)C * 2u; }
    const size_t kstep = (size_t)(BK * 2);
    const unsigned ldsw = (unsigned)wid * 1024u;
    const int aoff = lds_byte(wr * 64 + fr, fq * 8), boff = lds_byte(wc * 32 + fr, fq * 8);
#define PG8_SA(b, h) (((b) * 2 + (h)) * HTB)
#define PG8_SB(b, h) ((4 + (b) * 2 + (h)) * HTB)
#define PG8_STAGE(bufoff, gbase, voff, pitch) do { const char* _g0 = (const char*)(gbase); const char* _g1 = _g0 + (size_t)(pitch) * 64; asm volatile("" : "+s"(_g0), "+s"(_g1)); \
        __builtin_amdgcn_global_load_lds((const unsigned*)(_g0 + (voff)), (PG8_LAS unsigned*)(lds + (bufoff) + ldsw), 16, 0, 0); \
        __builtin_amdgcn_global_load_lds((const unsigned*)(_g1 + (voff)), (PG8_LAS unsigned*)(lds + (bufoff) + ldsw + 8192), 16, 0, 0); } while (0)
#define PG8_LDA(dst, b, h) do { _Pragma("unroll") for (int m = 0; m < 4; ++m) _Pragma("unroll") for (int k = 0; k < 2; ++k) dst[m][k] = *(const PG8_LAS bf16x8*)(lds + PG8_SA(b, h) + aoff + m * 2048 + k * 1024); } while (0)
#define PG8_LDB(dst, b, h) do { _Pragma("unroll") for (int n = 0; n < 2; ++n) _Pragma("unroll") for (int k = 0; k < 2; ++k) dst[n][k] = *(const PG8_LAS bf16x8*)(lds + PG8_SB(b, h) + boff + n * 2048 + k * 1024); } while (0)
#define PG8_MMA(ai, bj, At, Bt) do { __builtin_amdgcn_s_setprio(1); _Pragma("unroll") for (int m = 0; m < 4; ++m) _Pragma("unroll") for (int n = 0; n < 2; ++n) _Pragma("unroll") for (int k = 0; k < 2; ++k) \
        acc[ai][bj][m][n] = __builtin_amdgcn_mfma_f32_16x16x32_bf16(Bt[n][k], At[m][k], acc[ai][bj][m][n], 0, 0, 0); __builtin_amdgcn_s_setprio(0); } while (0)
#define PG8_WAIT_V(n) asm volatile("s_waitcnt vmcnt(" #n ")" ::: "memory")
#define PG8_WAIT_L(n) asm volatile("s_waitcnt lgkmcnt(" #n ")" ::: "memory")
#define PG8_BAR __builtin_amdgcn_s_barrier()
#define PG8_SCHED __builtin_amdgcn_sched_barrier(0)
    Unit cur, nxt; int ui = 0;
    if (!S.next(0, cur)) return;
    f32x4 acc[2][2][4][2];
#pragma unroll
    for (int a = 0; a < 2; ++a)
#pragma unroll
        for (int b = 0; b < 2; ++b)
#pragma unroll
            for (int m = 0; m < 4; ++m)
#pragma unroll
                for (int n = 0; n < 2; ++n) acc[a][b][m][n] = (f32x4){0.f, 0.f, 0.f, 0.f};
    bf16x8 At[4][2], B0[2][2], B1[2][2];
    unsigned vAc = rA0 * cur.pitchA + cO0, vBc = rB0 * cur.pitchB + cO0, vAn, vBn;
    PG8_STAGE(PG8_SB(0, 0), cur.B0, vBc, cur.pitchB); PG8_STAGE(PG8_SB(0, 1), cur.B1, vBc, cur.pitchB); PG8_STAGE(PG8_SA(0, 0), cur.A0, vAc, cur.pitchA); PG8_STAGE(PG8_SA(0, 1), cur.A1, vAc, cur.pitchA);
    if (wr == 1) PG8_BAR;
    PG8_WAIT_V(2); PG8_BAR;
    PG8_STAGE(PG8_SB(1, 0), cur.B0 + kstep, vBc, cur.pitchB); PG8_STAGE(PG8_SA(1, 0), cur.A0 + kstep, vAc, cur.pitchA); PG8_STAGE(PG8_SB(1, 1), cur.B1 + kstep, vBc, cur.pitchB);
    PG8_WAIT_V(6); PG8_BAR;
    for (;;) {
        const bool has_next = S.next(ui + 1, nxt);
        if (!has_next) nxt = cur;
        { int t2 = tid; asm volatile("" : "+v"(t2)); int R, C; stage_rc(t2 * 16, R, C);
          const unsigned rb = (unsigned)(Epi::PERM ? ((R & ~31) + perm32(R & 31)) : R);
          vAn = (unsigned)R * nxt.pitchA + (unsigned)C * 2u; vBn = rb * nxt.pitchB + (unsigned)C * 2u; }
        const int nt = cur.nt;
        for (int t = 0; t < nt; t += 2) {
            const bool last = (t == nt - 2);
            const char* a1_1 = cur.A1 + (size_t)(t + 1) * kstep;
            const char* a2_0 = last ? nxt.A0 : cur.A0 + (size_t)(t + 2) * kstep; const char* a2_1 = last ? nxt.A1 : cur.A1 + (size_t)(t + 2) * kstep;
            const char* b2_0 = last ? nxt.B0 : cur.B0 + (size_t)(t + 2) * kstep; const char* b2_1 = last ? nxt.B1 : cur.B1 + (size_t)(t + 2) * kstep;
            const unsigned vA2 = last ? vAn : vAc, vB2 = last ? vBn : vBc, pA2 = last ? nxt.pitchA : cur.pitchA, pB2 = last ? nxt.pitchB : cur.pitchB;
            PG8_LDB(B0, 0, 0); PG8_LDB(B1, 0, 1); PG8_SCHED; PG8_LDA(At, 0, 0); PG8_STAGE(PG8_SA(1, 1), a1_1, vAc, cur.pitchA);
            PG8_WAIT_V(8); PG8_WAIT_L(0); PG8_BAR; PG8_MMA(0, 0, At, B0); PG8_MMA(0, 1, At, B1); PG8_BAR; PG8_SCHED;
            PG8_LDA(At, 0, 1); PG8_STAGE(PG8_SB(0, 0), b2_0, vB2, pB2); PG8_STAGE(PG8_SB(0, 1), b2_1, vB2, pB2); PG8_STAGE(PG8_SA(0, 0), a2_0, vA2, pA2);
            PG8_WAIT_V(8); PG8_WAIT_L(0); PG8_BAR; PG8_MMA(1, 0, At, B0); PG8_MMA(1, 1, At, B1); PG8_BAR; PG8_SCHED;
            PG8_LDB(B0, 1, 0); PG8_LDB(B1, 1, 1); PG8_SCHED; PG8_LDA(At, 1, 0); PG8_STAGE(PG8_SA(0, 1), a2_1, vA2, pA2);
            PG8_WAIT_V(8); PG8_WAIT_L(0); PG8_BAR; PG8_MMA(0, 0, At, B0); PG8_MMA(0, 1, At, B1); PG8_BAR; PG8_SCHED;
            PG8_LDA(At, 1, 1); PG8_STAGE(PG8_SB(1, 0), b2_0 + kstep, vB2, pB2); PG8_STAGE(PG8_SB(1, 1), b2_1 + kstep, vB2, pB2); PG8_STAGE(PG8_SA(1, 0), a2_0 + kstep, vA2, pA2);
            PG8_WAIT_V(8); PG8_WAIT_L(0); PG8_BAR; PG8_MMA(1, 0, At, B0); PG8_MMA(1, 1, At, B1); PG8_BAR; PG8_SCHED;
        }
        if (PG8_ALIGN_EPI) { if (wr == 0) PG8_BAR; }
        { int l2 = lane; asm volatile("" : "+v"(l2)); E(acc, cur, wr, wc, l2 & 15, l2 >> 4); }
        if (!has_next) break;
#pragma unroll
        for (int a = 0; a < 2; ++a)
#pragma unroll
            for (int b = 0; b < 2; ++b)
#pragma unroll
                for (int m = 0; m < 4; ++m)
#pragma unroll
                    for (int n = 0; n < 2; ++n) acc[a][b][m][n] = (f32x4){0.f, 0.f, 0.f, 0.f};
        cur = nxt; ++ui;
        vAc = vAn; vBc = vBn;
        if (PG8_ALIGN_EPI) { if (wr == 1) PG8_BAR; }
    }
    PG8_WAIT_V(0);
    if (!PG8_ALIGN_EPI) { if (wr == 0) PG8_BAR; }
    PG8_BAR;
#undef PG8_SA
#undef PG8_SB
#undef PG8_STAGE
#undef PG8_LDA
#undef PG8_LDB
#undef PG8_MMA
#undef PG8_WAIT_V
#undef PG8_WAIT_L
#undef PG8_BAR
#undef PG8_SCHED
}
}
using pg8::Unit;

struct Args {
    const float *x, *c, *ctx, *c_ctx, *w_ada, *b_ada, *norm1_g, *norm2_g, *w_in, *conv_w, *conv_b, *lru_wa, *lru_ba, *lru_wx, *lru_bx, *lru_lambda,
        *w_lru_out, *w_pool, *pool_scale, *w_fourier, *b_gate, *w_out, *w_ffn_in, *w_ffn_out, *norm_f_g;
    float* out; unsigned char* ws; int ph_lo, ph_hi;
};

typedef const __attribute__((address_space(4))) Args* KP;
struct PlainSched {
    pg8::TileOrder T; const char* A; const char* B; unsigned pitchA, pitchB; int nt;
    int extra, xn, xnt;
    __device__ bool next(int i, Unit& u) const {
        int pm, pn; int ks = 0, nt_ = nt, aux = 0;
        if (!T.get(i, pm, pn)) { const int e = i * T.G + T.c - T.nwg; if (e >= extra) return false; pm = 64; pn = e % xn; ks = e / xn; nt_ = xnt; aux = (xnt != nt) ? 1 + ks : 0; }
        u.A0 = A + (size_t)pm * 256 * pitchA + (size_t)ks * xnt * 128; u.A1 = u.A0 + (size_t)128 * pitchA; u.B0 = B + (size_t)pn * 256 * pitchB + (size_t)ks * xnt * 128; u.B1 = u.B0 + (size_t)128 * pitchB;
        u.pitchA = pitchA; u.pitchB = pitchB; u.nt = nt_; u.pm = pm; u.pn = pn; u.aux = aux; return true;
    }
};
struct MergeSched {
    pg8::TileOrder T; const char *ALRU, *PL, *FO, *WLO, *WPOOL, *WF;
    __device__ bool next(int i, Unit& u) const {
        int pm, pn; const int ti = i / 3, pass = i - 3 * ti; if (!T.get(ti, pm, pn)) return false;
        if (pass == 0) { u.pitchA = DLRU * 2; u.pitchB = DLRU * 2; u.nt = DLRU / 64; u.A0 = ALRU + (size_t)pm * 256 * u.pitchA; u.B0 = WLO + (size_t)pn * 256 * u.pitchB; }
        else if (pass == 1) { u.pitchA = DP * 2; u.pitchB = 128 * 2; u.nt = 2; u.A0 = PL + (size_t)pm * 256 * u.pitchA + (size_t)(pn >> 1) * 128 * 2; u.B0 = WPOOL + (size_t)pn * 256 * u.pitchB; }
        else { u.pitchA = DFO * 2; u.pitchB = DFO * 2; u.nt = DFO / 64; u.A0 = FO + (size_t)pm * 256 * u.pitchA; u.B0 = WF + (size_t)pn * 256 * u.pitchB; }
        u.A1 = u.A0 + (size_t)128 * u.pitchA; u.B1 = u.B0 + (size_t)128 * u.pitchB; u.pm = pm; u.pn = pn; u.aux = pass; return true;
    }
};
struct ChDftSched {
    int G, c; const char *DCH, *P; int isctx;
    __device__ bool next(int i, Unit& u) const {
        const int Lq = i * G + c; if (Lq >= (isctx ? 4 : 256)) return false;
        const int T = isctx ? 64 : (Lq & 63), g = isctx ? Lq : (Lq >> 6);
        u.A0 = DCH; u.A1 = DCH + 128 * 256; u.pitchA = 256; u.nt = 2;
        if (T < 64) { u.B0 = P + ((size_t)(2 * T) * PP + I_XC + g * 128) * 2; u.B1 = u.B0 + (size_t)PP * 2; u.pitchB = 128u * PP * 2u; }
        else { u.B0 = P + ((size_t)L * PP + I_XC + g * 128) * 2; u.pitchB = PP * 2; u.B1 = u.B0 + (size_t)128 * PP * 2; }
        u.pm = T; u.pn = g; u.aux = 0; return true;
    }
};
struct FftASched {
    int G, c; const char *DA, *YT2;
    __device__ bool next(int i, Unit& u) const {
        const int Lq = i * G + c; if (Lq >= 256) return false;
        u.A0 = DA; u.A1 = DA + 128 * 512; u.pitchA = 512; u.nt = 4;
        u.B0 = YT2 + (size_t)Lq * 256 * 512; u.B1 = u.B0 + 128 * 512; u.pitchB = 512; u.pm = Lq; u.pn = 0; u.aux = 0; return true;
    }
};
struct FftCSched {
    int G, c; const char *E, *ZT, *DC, *YC; int nU;
    __device__ bool next(int i, Unit& u) const {
        const int Lq = i * G + c; if (Lq >= nU) return false;
        if (Lq < 256) { const int k1 = Lq >> 1, ch = Lq & 1;
            u.A0 = E + (size_t)k1 * 128 * 512; u.A1 = u.A0 + 128 * 512; u.pitchA = 512; u.nt = 4;
            u.B0 = ZT + ((size_t)k1 * 512 + ch * 256) * 512; u.B1 = u.B0 + 128 * 512; u.pitchB = 512; u.pm = k1; u.pn = ch; u.aux = 0; }
        else { const int ch = Lq - 256;
            u.A0 = DC; u.A1 = DC + 128 * 1024; u.pitchA = 1024; u.nt = 8;
            u.B0 = YC + (size_t)ch * 256 * 1024; u.B1 = u.B0 + 128 * 1024; u.pitchB = 1024; u.pm = 0; u.pn = ch; u.aux = 1; }
        return true;
    }
};

struct EpiWin {
    static constexpr bool PERM = true;
    bf16* P; bf16* GT; const float* b_gate; float* XA1;
    __device__ __forceinline__ void operator()(const f32x4 (&acc)[2][2][4][2], const Unit& u, int wr, int wc, int fr, int fq) const {
        const int row0 = u.pm * 256 + wr * 64 + fr, col0 = u.pn * 256 + wc * 32 + 8 * fq;
        if (u.aux) {
#pragma unroll
            for (int bj = 0; bj < 2; ++bj)
#pragma unroll
                for (int ai = 0; ai < 2; ++ai)
#pragma unroll
                    for (int m = 0; m < 4; ++m) { float* o = XA1 + (size_t)(u.aux - 1) * LC * DLRU + (size_t)(wr * 64 + fr + ai * 128 + m * 16) * DLRU + col0 + bj * 128;
                        *(f32x4*)o = acc[ai][bj][m][0]; *(f32x4*)(o + 4) = acc[ai][bj][m][1]; }
            return;
        }
        const int tid = (wr * 4 + wc) * 64 + fq * 16 + fr;
        bf16* gt = GT + ((size_t)(u.pm * 24 + (u.pn - 12)) * 16 * 512 + tid) * 8;
        const int mode = (u.pn >= 12) ? 2 : ((u.pn >= 4 && u.pn < 8) ? 1 : 0);
#pragma unroll
        for (int bj = 0; bj < 2; ++bj) {
            f32x4 b0 = (f32x4){0.f, 0.f, 0.f, 0.f}, b1 = b0;
            if (mode == 2) { b0 = *(const f32x4*)(b_gate + col0 + bj * 128 - I_G); b1 = *(const f32x4*)(b_gate + col0 + bj * 128 - I_G + 4); }
#pragma unroll
            for (int ai = 0; ai < 2; ++ai)
#pragma unroll
                for (int m = 0; m < 4; ++m) {
                    f32x4 v0 = acc[ai][bj][m][0] + b0, v1 = acc[ai][bj][m][1] + b1;
                    if (mode == 1) { for (int j = 0; j < 4; ++j) { v0[j] = gelu_tanh(v0[j]); v1[j] = gelu_tanh(v1[j]); } }
                    else if (mode == 2) { for (int j = 0; j < 4; ++j) { v0[j] = sigmoidf_(v0[j]); v1[j] = sigmoidf_(v1[j]); } }
                    u32x4 w; w.x = pk2(v0[0], v0[1]); w.y = pk2(v0[2], v0[3]); w.z = pk2(v1[0], v1[1]); w.w = pk2(v1[2], v1[3]);
                    if (mode == 2) *(u32x4*)(gt + ((ai * 4 + m) * 2 + bj) * 4096) = w;
                    else *(u32x4*)(P + (size_t)(row0 + ai * 128 + m * 16) * PP + col0 + bj * 128) = w;
                }
        }
    }
};
struct EpiRes {
    static constexpr bool PERM = false;
    const float* resx; float* outx; const float* resc; float* outc; const float* gx; const float* gc; float* part;
    __device__ __forceinline__ void operator()(const f32x4 (&acc)[2][2][4][2], const Unit& u, int wr, int wc, int fr, int fq) const {
        const bool isc = (u.pm == 64);
        const float* res = isc ? resc : resx; float* out = isc ? outc : outx; const float* g = isc ? gc : gx;
        const int row0 = (isc ? 0 : u.pm * 256) + wr * 64 + fr, col0 = u.pn * 256 + wc * 32 + 4 * fq;
#pragma unroll
        for (int bj = 0; bj < 2; ++bj)
#pragma unroll
            for (int n = 0; n < 2; ++n) {
                const int col = col0 + bj * 128 + 16 * n; const f32x4 gv = *(const f32x4*)(g + col);
                if (u.aux) {
#pragma unroll
                    for (int q = 0; q < 8; ++q) { const size_t o = (size_t)(u.aux - 1) * LC * D + (size_t)(row0 + (q >> 2) * 128 + (q & 3) * 16) * D + col; *(f32x4*)(part + o) = gv * acc[q >> 2][bj][q & 3][n]; }
                } else {
                    f32x4 r[8];
#pragma unroll
                    for (int q = 0; q < 8; ++q) r[q] = *(const f32x4*)(res + (size_t)(row0 + (q >> 2) * 128 + (q & 3) * 16) * D + col);
#pragma unroll
                    for (int q = 0; q < 8; ++q) __builtin_nontemporal_store(r[q] + gv * acc[q >> 2][bj][q & 3][n], (f32x4*)(out + (size_t)(row0 + (q >> 2) * 128 + (q & 3) * 16) * D + col));
                }
            }
    }
};
struct EpiFfi {
    static constexpr bool PERM = true;
    bf16* H;
    __device__ __forceinline__ void operator()(const f32x4 (&acc)[2][2][4][2], const Unit& u, int wr, int wc, int fr, int fq) const {
        const int row0 = u.pm * 256 + wr * 64 + fr, col0 = u.pn * 128 + wc * 32 + 8 * fq;
#pragma unroll
        for (int ai = 0; ai < 2; ++ai)
#pragma unroll
            for (int m = 0; m < 4; ++m) {
                float h[8];
#pragma unroll
                for (int n = 0; n < 2; ++n)
#pragma unroll
                    for (int j = 0; j < 4; ++j) h[4 * n + j] = siluf_(acc[ai][0][m][n][j]) * acc[ai][1][m][n][j];
                u32x4 w; w.x = pk2(h[0], h[1]); w.y = pk2(h[2], h[3]); w.z = pk2(h[4], h[5]); w.w = pk2(h[6], h[7]);
                __builtin_nontemporal_store(w, (u32x4*)(H + (size_t)(row0 + ai * 128 + m * 16) * DFF + col0));
            }
    }
};
struct EpiMerge {
    static constexpr bool PERM = true;
    bf16* MG; const bf16* GT; bf16* SCR; const float* pool_scale;
    __device__ __forceinline__ void operator()(const f32x4 (&acc)[2][2][4][2], const Unit& u, int wr, int wc, int fr, int fq) const {
        const int row0 = u.pm * 256 + wr * 64 + fr, col0 = u.pn * 256 + wc * 32 + 8 * fq, pass = u.aux;
        const int tid = (wr * 4 + wc) * 64 + fq * 16 + fr;
        const bf16* gt = GT + ((size_t)(u.pm * 24 + pass * 8 + u.pn) * 16 * 512 + tid) * 8;
        bf16* scr = SCR + ((size_t)blockIdx.x * 16 * 512 + tid) * 8;
#pragma unroll
        for (int bj = 0; bj < 2; ++bj) {
            const int col = col0 + bj * 128;
            u32x4 gw[8], pw[8];
#pragma unroll
            for (int q = 0; q < 8; ++q) gw[q] = *(const u32x4*)(gt + (q * 2 + bj) * 4096);
            if (pass != 0) {
#pragma unroll
                for (int q = 0; q < 8; ++q) pw[q] = *(const u32x4*)(scr + (q * 2 + bj) * 4096);
            }
            f32x4 s0 = (f32x4){1.f, 1.f, 1.f, 1.f}, s1 = s0;
            if (pass == 1) { s0 = *(const f32x4*)(pool_scale + col); s1 = *(const f32x4*)(pool_scale + col + 4); }
#pragma unroll
            for (int q = 0; q < 8; ++q) {
                const int ai = q >> 2, m = q & 3;
                f32x4 v0 = acc[ai][bj][m][0] * s0, v1 = acc[ai][bj][m][1] * s1;
                v0[0] *= bflo(gw[q].x); v0[1] *= bfhi(gw[q].x); v0[2] *= bflo(gw[q].y); v0[3] *= bfhi(gw[q].y);
                v1[0] *= bflo(gw[q].z); v1[1] *= bfhi(gw[q].z); v1[2] *= bflo(gw[q].w); v1[3] *= bfhi(gw[q].w);
                if (pass != 0) {
                    v0[0] += bflo(pw[q].x); v0[1] += bfhi(pw[q].x); v0[2] += bflo(pw[q].y); v0[3] += bfhi(pw[q].y);
                    v1[0] += bflo(pw[q].z); v1[1] += bfhi(pw[q].z); v1[2] += bflo(pw[q].w); v1[3] += bfhi(pw[q].w); }
                u32x4 w; w.x = pk2(v0[0], v0[1]); w.y = pk2(v0[2], v0[3]); w.z = pk2(v1[0], v1[1]); w.w = pk2(v1[2], v1[3]);
                if (pass == 2) __builtin_nontemporal_store(w, (u32x4*)(MG + (size_t)(row0 + ai * 128 + m * 16) * D + col));
                else *(u32x4*)(scr + (q * 2 + bj) * 4096) = w;
            }
        }
    }
};
constexpr float RS128 = 0.08838834764831845f;
template <bool ISX> struct EpiChDft {
    static constexpr bool PERM = true;
    bf16* YT2; bf16* YC;
    __device__ __forceinline__ void operator()(const f32x4 (&acc)[2][2][4][2], const Unit& u, int wr, int wc, int fr, int fq) const {
        const int T = u.pm, g = u.pn; constexpr bool isx = ISX;
        bf16* base = isx ? YT2 + (size_t)T * 512 : YC; constexpr int sC = isx ? 32768 : 512, sR = isx ? 128 : 256, sB = isx ? 256 : 128;
        bf16* p0 = base + (size_t)(g * 128 + wr * 64 + fr) * sC + wc * 32 + 8 * fq;
#pragma unroll
        for (int ai = 0; ai < 2; ++ai)
#pragma unroll
            for (int m = 0; m < 4; ++m)
#pragma unroll
                for (int bj = 0; bj < 2; ++bj) {
                    const f32x4 v0 = acc[ai][bj][m][0] * RS128, v1 = acc[ai][bj][m][1] * RS128;
                    u32x4 w; w.x = pk2(v0[0], v0[1]); w.y = pk2(v0[2], v0[3]); w.z = pk2(v1[0], v1[1]); w.w = pk2(v1[2], v1[3]);
                    *(u32x4*)(p0 + (size_t)(m * 16) * sC + ai * sR + bj * sB) = w;
                }
    }
};
struct EpiFftA {
    static constexpr bool PERM = true;
    bf16* ZT;
    __device__ __forceinline__ void operator()(const f32x4 (&acc)[2][2][4][2], const Unit& u, int wr, int wc, int fr, int fq) const {
        const int T = u.pm;
#pragma unroll
        for (int ai = 0; ai < 2; ++ai)
#pragma unroll
            for (int m = 0; m < 4; ++m) {
                const int k1 = wr * 64 + m * 16 + fr;
#pragma unroll
                for (int bj = 0; bj < 2; ++bj) {
                    const int cc = 2 * T + bj, t_lo = wc * 32 + 8 * fq;
                    const f32x4 v0 = acc[ai][bj][m][0] * RS128, v1 = acc[ai][bj][m][1] * RS128;
                    u32x4 w; w.x = pk2(v0[0], v0[1]); w.y = pk2(v0[2], v0[3]); w.z = pk2(v1[0], v1[1]); w.w = pk2(v1[2], v1[3]);
                    *(u32x4*)(ZT + (((size_t)k1 * 512 + cc) * 2 + ai) * 128 + t_lo) = w;
                }
            }
    }
};
struct EpiFftC {
    static constexpr bool PERM = true;
    bf16* FO;
    __device__ __forceinline__ void operator()(const f32x4 (&acc)[2][2][4][2], const Unit& u, int wr, int wc, int fr, int fq) const {
        const bool isc = u.aux != 0; const float sc = isc ? 0.0625f : RS128;
        const int rbase = isc ? L : u.pm, rstr = isc ? 1 : 128;
        bf16* p0 = FO + (size_t)(rbase + (wr * 64 + fr) * rstr) * DFO + u.pn * 256 + wc * 32 + 8 * fq;
#pragma unroll
        for (int ai = 0; ai < 2; ++ai) {
            if (ai == 1 && !isc) continue;
#pragma unroll
            for (int m = 0; m < 4; ++m)
#pragma unroll
                for (int bj = 0; bj < 2; ++bj) {
                    const f32x4 v0 = acc[ai][bj][m][0] * sc, v1 = acc[ai][bj][m][1] * sc;
                    u32x4 w; w.x = pk2(v0[0], v0[1]); w.y = pk2(v0[2], v0[3]); w.z = pk2(v1[0], v1[1]); w.w = pk2(v1[2], v1[3]);
                    *(u32x4*)(p0 + (size_t)((ai * 128 + m * 16) * rstr) * DFO + bj * 128) = w;
                }
        }
    }
};

__device__ __forceinline__ void transpose_item(const float* W, int srcN, bf16* WT, int dpitch, int k0, int n0, int drow0, LAS float* scr, int lane) {
    f32x4 v[16];
#pragma unroll
    for (int i = 0; i < 16; ++i) v[i] = *(const f32x4*)(W + (size_t)(k0 + 4 * i + (lane >> 4)) * srcN + n0 + (lane & 15) * 4);
#pragma unroll
    for (int i = 0; i < 16; ++i) { LAS float* s = scr + (4 * i + (lane >> 4)) * 65 + (lane & 15) * 4; s[0] = v[i].x; s[1] = v[i].y; s[2] = v[i].z; s[3] = v[i].w; }
    asm volatile("s_waitcnt lgkmcnt(0)" ::: "memory");
    const int c = lane & 7;
#pragma unroll
    for (int j = 0; j < 8; ++j) { const int n = (lane >> 3) + 8 * j; const LAS float* s = scr + (8 * c) * 65 + n;
        u32x4 o; o.x = pk2(s[0 * 65], s[1 * 65]); o.y = pk2(s[2 * 65], s[3 * 65]); o.z = pk2(s[4 * 65], s[5 * 65]); o.w = pk2(s[6 * 65], s[7 * 65]);
        *(u32x4*)(WT + (size_t)(drow0 + n) * dpitch + k0 + 8 * c) = o; }
    asm volatile("s_waitcnt lgkmcnt(0)" ::: "memory");
}
constexpr int CI_IN = 32 * 144, CI_LO = 16 * 32, CI_POOL = 4 * 16, CI_F = 8 * 32, CI_OUT = 32 * 32, CI_FFI = 32 * 176, CI_FFO = 88 * 32, CI_G = 32 * 4;
constexpr int CI_LAYER = CI_IN + CI_LO + CI_POOL + CI_F + CI_OUT + CI_FFI + CI_FFO + CI_G;
__device__ __forceinline__ void conv_item(KP a, int l, int r, LAS float* scr, int lane) {
    unsigned char* wl = a->ws + OFF_W + (size_t)l * W_LAYER;
    if (r < CI_IN) { const int kb = r / 144, nb = r % 144; transpose_item(a->w_in + (size_t)l * D * DIN, DIN, (bf16*)(wl + W_IN), D, 64 * kb, 64 * nb, 64 * nb, scr, lane); return; } r -= CI_IN;
    if (r < CI_LO) { const int kb = r / 32, nb = r % 32; transpose_item(a->w_lru_out + (size_t)l * DLRU * D, D, (bf16*)(wl + W_LO), DLRU, 64 * kb, 64 * nb, 64 * nb, scr, lane); return; } r -= CI_LO;
    if (r < CI_POOL) { const int g = r / 16, rr = r % 16, kb = rr / 8, nb = rr % 8; transpose_item(a->w_pool + (size_t)(l * 4 + g) * 128 * 512, 512, (bf16*)(wl + W_POOL), 128, 64 * kb, 64 * nb, g * 512 + 64 * nb, scr, lane); return; } r -= CI_POOL;
    if (r < CI_F) { const int kb = r / 32, nb = r % 32; transpose_item(a->w_fourier + (size_t)l * DFO * D, D, (bf16*)(wl + W_F), DFO, 64 * kb, 64 * nb, 64 * nb, scr, lane); return; } r -= CI_F;
    if (r < CI_OUT) { const int kb = r / 32, nb = r % 32; transpose_item(a->w_out + (size_t)l * D * D, D, (bf16*)(wl + W_OUT), D, 64 * kb, 64 * nb, 64 * nb, scr, lane); return; } r -= CI_OUT;
    if (r < CI_FFI) { const int kb = r / 176, nb = r % 176, n0 = 64 * nb, half = n0 >= DFF ? 1 : 0, hu = n0 - half * DFF;
        transpose_item(a->w_ffn_in + (size_t)l * D * 2 * DFF, 2 * DFF, (bf16*)(wl + W_FFI), D, 64 * kb, n0, (hu >> 7) * 256 + half * 128 + (hu & 127), scr, lane); return; } r -= CI_FFI;
    if (r < CI_FFO) { const int kb = r / 32, nb = r % 32; transpose_item(a->w_ffn_out + (size_t)l * DFF * D, D, (bf16*)(wl + W_FFO), DFF, 64 * kb, 64 * nb, 64 * nb, scr, lane); return; } r -= CI_FFO;
    { const int idx = r / 4, rr = r % 4, kb = rr / 2, nb = rr % 2, d = idx >> 4, mat = (idx >> 3) & 1, h = idx & 7;
      const float* src = (mat ? a->lru_wx : a->lru_wa) + (size_t)((l * 2 + d) * 8 + h) * 16384;
      transpose_item(src, 128, (bf16*)(wl + W_G) + (size_t)idx * 16384, 128, 64 * kb, 64 * nb, 64 * nb, scr, lane); }
}
__device__ __forceinline__ void table_elem(KP a, int idx) {
    float s, c;
    if (idx < 256 * 128) { const int n = idx / 128, j = idx % 128, m = n & 127, ph = (m * j) & 127; sincospif((float)ph * (1.0f / 64.0f), &s, &c);
        ((bf16*)(a->ws + OFF_DCH))[idx] = (bf16)f2bf(n < 128 ? c : -s); return; } idx -= 256 * 128;
    if (idx < 256 * 256) { const int n = idx / 256, k = idx % 256, k1 = n & 127, rip = n >> 7, t = k & 127, ri = k >> 7, ph = (k1 * t) & 127; sincospif((float)ph * (1.0f / 64.0f), &s, &c);
        const float v = rip == 0 ? (ri == 0 ? c : s) : (ri == 0 ? -s : c); ((bf16*)(a->ws + OFF_DA))[idx] = (bf16)f2bf(v); return; } idx -= 256 * 256;
    if (idx < 256 * 512) { const int k = idx / 512, kk = idx % 512, t = kk & 255, ri = kk >> 8, ph = (k * t) & 255; sincospif((float)ph * (1.0f / 128.0f), &s, &c);
        ((bf16*)(a->ws + OFF_DC))[idx] = (bf16)f2bf(ri == 0 ? c : s); return; } idx -= 256 * 512;
    { const int rr = idx / 256, k = idx % 256; float v = 0.f;
      if (rr < 16384) { const int k1 = rr >> 7, k2 = rr & 127, kk = k1 + 128 * k2, t_lo = k & 127, ri = k >> 7, ph = (kk * t_lo) & 16383; sincospif((float)ph * (1.0f / 8192.0f), &s, &c); v = ri == 0 ? c : s; }
      ((bf16*)(a->ws + OFF_E))[idx] = (bf16)f2bf(v); }
}
constexpr int N_TABLE = 256 * 128 + 256 * 256 + 256 * 512 + (16384 + 128) * 256;

__device__ __forceinline__ void conv_range(KP a, int l, int r_lo, int r_hi, int b0, int G, LAS unsigned char* lds) {
    if ((int)blockIdx.x < b0) return;
    int tid_ = threadIdx.x; asm volatile("" : "+v"(tid_)); const int tid = tid_, lane = tid & 63, wave = tid >> 6;
    LAS float* scr = (LAS float*)(lds + wave * 16896);
    for (int it = r_lo + ((int)blockIdx.x - b0) * NWAVES + wave; it < r_hi; it += (G - b0) * NWAVES) conv_item(a, l, it, scr, lane);
}
constexpr int CR_FFI0 = CI_IN + CI_LO + CI_POOL + CI_F + CI_OUT, CR_G0 = CR_FFI0 + CI_FFI + CI_FFO;
__device__ __forceinline__ void phase_prologue(KP a, LAS unsigned char* lds, int G) {
    int tid_ = threadIdx.x; asm volatile("" : "+v"(tid_)); const int tid = tid_, lane = tid & 63, wave = tid >> 6;
    for (int it = blockIdx.x; it < 96; it += G) {
        const int l = it / 48, nb = it % 48;
        const float* Wl = a->w_ada + (size_t)l * D * 6 * D + nb * 256 + lane * 4;
        f32x4 a0 = (f32x4){0.f, 0.f, 0.f, 0.f}, a1 = a0;
        for (int k0 = wave * 256; k0 < wave * 256 + 256; k0 += 16) {
            f32x4 w[16];
#pragma unroll
            for (int j = 0; j < 16; ++j) w[j] = *(const f32x4*)(Wl + (size_t)(k0 + j) * 6 * D);
#pragma unroll
            for (int j = 0; j < 16; ++j) { const float sx = siluf_(a->c[k0 + j]), sc = siluf_(a->c_ctx[k0 + j]); a0 += w[j] * sx; a1 += w[j] * sc; }
        }
        LAS f32x4* red = (LAS f32x4*)lds;
        red[(wave * 2 + 0) * 64 + lane] = a0; red[(wave * 2 + 1) * 64 + lane] = a1;
        __syncthreads();
        if (tid < 128) { const int s = tid >> 6, ln = tid & 63; f32x4 r = *(const f32x4*)(a->b_ada + (size_t)l * 6 * D + nb * 256 + ln * 4);
            for (int w = 0; w < 8; ++w) r += red[(w * 2 + s) * 64 + ln];
            *(f32x4*)((float*)(a->ws + OFF_MODS) + (size_t)(l * 2 + s) * 6 * D + nb * 256 + ln * 4) = r; }
        __syncthreads();
    }
    for (int idx = blockIdx.x * NTHREADS + tid; idx < LC * D / 4; idx += G * NTHREADS) ((f32x4*)(a->ws + OFF_XC))[idx] = ((const f32x4*)a->ctx)[idx];
    for (int idx = blockIdx.x * NTHREADS + tid; idx < N_TABLE; idx += G * NTHREADS) table_elem(a, idx);
    __syncthreads();
    conv_range(a, 0, 0, CR_FFI0, 0, G, lds);
    conv_range(a, 0, CR_G0, CI_LAYER, 0, G, lds);
}

template <int RB>
__device__ __forceinline__ void phase_norm(const float* resx, float* resc, const float* gvec, const float* modx, const float* modc, int sh_idx, bf16* U, int row_lo, int row_hi, int wv0, int nwv, const float* part, int nsum) {
    int tid_ = threadIdx.x; asm volatile("" : "+v"(tid_)); const int tid = tid_, lane = tid & 63, wave = tid >> 6;
    for (int rowb = row_lo + (wv0 + wave) * RB; rowb < row_hi; rowb += nwv * RB) {
        f32x4 v[RB][8]; float s[RB];
#pragma unroll
        for (int b = 0; b < RB; ++b) { const int row = rowb + b; s[b] = 0.f;
            if (row < row_hi) { const float* xr = (row >= L) ? resc + (size_t)(row - L) * D : resx + (size_t)row * D;
#pragma unroll
                for (int j = 0; j < 8; ++j) v[b][j] = *(const f32x4*)(xr + 4 * lane + 256 * j);
                if (row >= L && nsum > 0) {
                    for (int s2 = 0; s2 < nsum; ++s2) {
#pragma unroll
                        for (int j = 0; j < 8; ++j) v[b][j] += *(const f32x4*)(part + ((size_t)s2 * LC + (row - L)) * D + 4 * lane + 256 * j); }
#pragma unroll
                    for (int j = 0; j < 8; ++j) *(f32x4*)(resc + (size_t)(row - L) * D + 4 * lane + 256 * j) = v[b][j]; } } }
#pragma unroll
        for (int b = 0; b < RB; ++b) { const int row = rowb + b;
            if (row < row_hi) {
#pragma unroll
                for (int j = 0; j < 8; ++j) s[b] += (v[b][j].x * v[b][j].x + v[b][j].y * v[b][j].y) + (v[b][j].z * v[b][j].z + v[b][j].w * v[b][j].w);
                const float rstd = 1.0f / sqrtf(wave_sum(s[b], lane) * (1.0f / D) + NORM_EPS);
                const float* mod = (row >= L) ? modc : modx;
#pragma unroll
                for (int j = 0; j < 8; ++j) { const int col = 4 * lane + 256 * j;
                    const f32x4 g = *(const f32x4*)(gvec + col), sh = *(const f32x4*)(mod + sh_idx * D + col), sc = *(const f32x4*)(mod + (sh_idx + 1) * D + col);
                    const f32x4 y = v[b][j] * rstd * g * (sc + 1.0f) + sh;
                    u32x2 w; w.x = pk2(y.x, y.y); w.y = pk2(y.z, y.w); *(u32x2*)(U + (size_t)row * D + col) = w; } } }
    }
}
__device__ __forceinline__ void phase_final(float* out, const float* gvec, int G) {
    int tid_ = threadIdx.x; asm volatile("" : "+v"(tid_)); const int tid = tid_, lane = tid & 63, wave = tid >> 6;
    const int gw = blockIdx.x * NWAVES + wave, NGW = G * NWAVES;
    for (int row = gw; row < L; row += NGW) {
        float* xr = out + (size_t)row * D;
        f32x4 v[8]; float s = 0.f;
#pragma unroll
        for (int j = 0; j < 8; ++j) { v[j] = *(const f32x4*)(xr + 4 * lane + 256 * j); s += (v[j].x * v[j].x + v[j].y * v[j].y) + (v[j].z * v[j].z + v[j].w * v[j].w); }
        const float rstd = 1.0f / sqrtf(wave_sum(s, lane) * (1.0f / D) + NORM_EPS);
#pragma unroll
        for (int j = 0; j < 8; ++j) { const int col = 4 * lane + 256 * j; const f32x4 g = *(const f32x4*)(gvec + col); *(f32x4*)(xr + col) = v[j] * rstd * g; }
    }
}

__device__ __forceinline__ void phase_pool(const bf16* P, bf16* PL, int G, int nrows) {
    const int total = nrows * 64;
    int tid_ = threadIdx.x; asm volatile("" : "+v"(tid_));
    for (int it = blockIdx.x * NTHREADS + tid_; it < total; it += G * NTHREADS) {
        const int row = it >> 6, c8 = it & 63, g = c8 >> 4, W = 2 << g;
        int base, w, width;
        if (row < L) { base = row & ~63; w = row & 63; width = 64; } else { base = L; w = row - L; width = 256; }
        int lo = w - W / 2, hi = lo + W; lo = lo < 0 ? 0 : lo; hi = hi > width ? width : hi;
        float sum[8] = {0.f, 0.f, 0.f, 0.f, 0.f, 0.f, 0.f, 0.f};
        u32x4 qq[16];
#pragma unroll
        for (int j = 0; j < 16; ++j) { const int p = lo + j; qq[j] = (p < hi) ? *(const u32x4*)(P + (size_t)(base + p) * PP + I_XB + 8 * c8) : (u32x4){0u, 0u, 0u, 0u}; }
#pragma unroll
        for (int j = 0; j < 16; ++j) { const u32x4 q = qq[j];
            sum[0] += bflo(q.x); sum[1] += bfhi(q.x); sum[2] += bflo(q.y); sum[3] += bfhi(q.y); sum[4] += bflo(q.z); sum[5] += bfhi(q.z); sum[6] += bflo(q.w); sum[7] += bfhi(q.w); }
        const u32x4 q = *(const u32x4*)(P + (size_t)row * PP + I_XB + 8 * c8);
        const float inv = 1.0f / (float)(hi - lo);
        u32x4 o; o.x = pk2(sum[0] * inv - bflo(q.x), sum[1] * inv - bfhi(q.x)); o.y = pk2(sum[2] * inv - bflo(q.y), sum[3] * inv - bfhi(q.y));
        o.z = pk2(sum[4] * inv - bflo(q.z), sum[5] * inv - bfhi(q.z)); o.w = pk2(sum[6] * inv - bflo(q.w), sum[7] * inv - bfhi(q.w));
        *(u32x4*)(PL + (size_t)row * DP + 8 * c8) = o;
    }
}

constexpr int XCV_P = 136;

constexpr int L3_XCV = 0, L3_GY = 2 * 17408, L3_CW = L3_GY + 2 * 16384;
static_assert(L3_CW + 2560 <= LDS_BYTES - 64, "lru3 lds");
template <bool PASS3>
__device__ __forceinline__ void phase_lru3(KP a, int l, LAS unsigned char* lds, int G, int nch) {
    int tid_ = threadIdx.x; asm volatile("" : "+v"(tid_)); const int tid = tid_;
    const int h = blockIdx.x & 7, step = G >> 3;
    const bf16* P = (const bf16*)(a->ws + OFF_P);
    const bf16* WG = (const bf16*)(a->ws + OFF_W + (size_t)l * W_LAYER + W_G);
    f32x2* AGG = (f32x2*)(a->ws + OFF_AGG);
    const float* CARRY = (const float*)(a->ws + OFF_CARRY);
    bf16* ALRU = (bf16*)(a->ws + OFF_ALRU);
    LAS float* CW = (LAS float*)(lds + L3_CW);
    for (int i = tid; i < 640; i += NTHREADS) CW[i] = (i < 512) ? a->conv_w[(size_t)(l * 4 + (i >> 7)) * DLRU + h * 128 + (i & 127)] : a->conv_b[(size_t)l * DLRU + h * 128 + (i - 512)];
    __syncthreads();
    bf16x8 wf[2][2][4];
    float ba_[2], bx_[2], sp_[2];
    {
        const int lane = tid & 63, n = 16 * (tid >> 6) + (lane & 15), quad = lane >> 4, cfull = h * 128 + n;
#pragma unroll
        for (int d = 0; d < 2; ++d) {
#pragma unroll
            for (int mtx = 0; mtx < 2; ++mtx)
#pragma unroll
                for (int ks = 0; ks < 4; ++ks) wf[d][mtx][ks] = *(const bf16x8*)(WG + (size_t)((d * 2 + mtx) * 8 + h) * 16384 + n * 128 + quad * 8 + ks * 32);
            ba_[d] = a->lru_ba[(size_t)(l * 2 + d) * DLRU + cfull]; bx_[d] = a->lru_bx[(size_t)(l * 2 + d) * DLRU + cfull];
            const float lam = a->lru_lambda[(size_t)(l * 2 + d) * DLRU + cfull]; sp_[d] = softplus_neg(lam);
        }
    }
    u32x4 q[2][4], gq[2];
    auto fetch = [&](int ch) {
        int tl = tid; asm volatile("" : "+v"(tl)); const int tr = tl >> 4, cf = h * 128 + (tl & 15) * 8;
        int rowbase, p0, seglen;
        if (ch < 256) { rowbase = 0; p0 = 64 * ch; seglen = L; } else { rowbase = L; p0 = 64 * (ch - 256); seglen = LC; }
        if (ch >= 256 && l == 1) {
            const float* XA1 = (const float*)(a->ws + OFF_PART);
#pragma unroll
            for (int rr = 0; rr < 2; ++rr)
#pragma unroll
                for (int k = 0; k < 4; ++k) { const int p = p0 + tr + 32 * rr + k - 2; u32x4 w = (u32x4){0u, 0u, 0u, 0u};
                    if (p >= 0 && p < seglen) { f32x4 v0 = (f32x4){0.f, 0.f, 0.f, 0.f}, v1 = v0;
                        for (int s2 = 0; s2 < 8; ++s2) { v0 += *(const f32x4*)(XA1 + ((size_t)s2 * LC + p) * DLRU + cf); v1 += *(const f32x4*)(XA1 + ((size_t)s2 * LC + p) * DLRU + cf + 4); }
                        w.x = pk2(v0.x, v0.y); w.y = pk2(v0.z, v0.w); w.z = pk2(v1.x, v1.y); w.w = pk2(v1.z, v1.w); }
                    q[rr][k] = w; }
        } else
#pragma unroll
        for (int rr = 0; rr < 2; ++rr)
#pragma unroll
            for (int k = 0; k < 4; ++k) { const int p = p0 + tr + 32 * rr + k - 2;
                q[rr][k] = (p >= 0 && p < seglen) ? *(const u32x4*)(P + (size_t)(rowbase + p) * PP + cf) : (u32x4){0u, 0u, 0u, 0u}; }
        if (PASS3) {
#pragma unroll
            for (int rr = 0; rr < 2; ++rr) gq[rr] = *(const u32x4*)(P + (size_t)(rowbase + p0 + tr + 32 * rr) * PP + I_YA + cf);
        }
    };
    int ch = blockIdx.x >> 3, it = 0;
    if (ch < nch) fetch(ch);
    for (; ch < nch; ch += step, ++it) {
        const int rowbase = ch < 256 ? 0 : L, p0 = ch < 256 ? 64 * ch : 64 * (ch - 256);
        LAS bf16* XCV = (LAS bf16*)(lds + L3_XCV + (it & 1) * 17408);
        LAS bf16* GY = (LAS bf16*)(lds + L3_GY + (it & 1) * 16384);
        int tl = tid; asm volatile("" : "+v"(tl));
        const int c8 = tl & 15, tr = tl >> 4, cf = h * 128 + c8 * 8, lane = tl & 63, n = 16 * (tl >> 6) + (lane & 15), quad = lane >> 4;
#pragma unroll
        for (int rr = 0; rr < 2; ++rr) {
            float o[8];
            { const f32x4 b0 = *(const LAS f32x4*)(CW + 512 + c8 * 8), b1 = *(const LAS f32x4*)(CW + 512 + c8 * 8 + 4);
              o[0] = b0.x; o[1] = b0.y; o[2] = b0.z; o[3] = b0.w; o[4] = b1.x; o[5] = b1.y; o[6] = b1.z; o[7] = b1.w; }
#pragma unroll
            for (int k = 0; k < 4; ++k) { const u32x4 v = q[rr][k];
                const f32x4 w0 = *(const LAS f32x4*)(CW + k * 128 + c8 * 8), w1 = *(const LAS f32x4*)(CW + k * 128 + c8 * 8 + 4);
                o[0] += w0.x * bflo(v.x); o[1] += w0.y * bfhi(v.x); o[2] += w0.z * bflo(v.y); o[3] += w0.w * bfhi(v.y);
                o[4] += w1.x * bflo(v.z); o[5] += w1.y * bfhi(v.z); o[6] += w1.z * bflo(v.w); o[7] += w1.w * bfhi(v.w); }
            u32x4 w; w.x = pk2(o[0], o[1]); w.y = pk2(o[2], o[3]); w.z = pk2(o[4], o[5]); w.w = pk2(o[6], o[7]);
            *(LAS u32x4*)(XCV + (tr + 32 * rr) * XCV_P + c8 * 8) = w;
            if (PASS3) *(LAS u32x4*)(GY + (tr + 32 * rr) * 128 + c8 * 8) = gq[rr];
        }
        float hin[2] = {0.f, 0.f};
        if (PASS3) { hin[0] = CARRY[((size_t)0 * NCH + ch) * DLRU + h * 128 + n]; hin[1] = CARRY[((size_t)1 * NCH + ch) * DLRU + h * 128 + n]; }
        if (ch + step < nch) fetch(ch + step);
        __syncthreads();
        float hf[4][4];
        const int p16 = (lane ^ 16) << 2, p32 = (lane ^ 32) << 2;
#pragma unroll
        for (int d = 0; d < 2; ++d) {
            f32x4 acc[2][4];
#pragma unroll
            for (int mtx = 0; mtx < 2; ++mtx)
#pragma unroll
                for (int rb = 0; rb < 4; ++rb) acc[mtx][rb] = (f32x4){0.f, 0.f, 0.f, 0.f};
#pragma unroll
            for (int ks = 0; ks < 4; ++ks)
#pragma unroll
                for (int rb = 0; rb < 4; ++rb) { const bf16x8 av = *(const LAS bf16x8*)(XCV + (16 * rb + (lane & 15)) * XCV_P + ks * 32 + quad * 8);
                    acc[0][rb] = __builtin_amdgcn_mfma_f32_16x16x32_bf16(av, wf[d][0][ks], acc[0][rb], 0, 0, 0);
                    acc[1][rb] = __builtin_amdgcn_mfma_f32_16x16x32_bf16(av, wf[d][1][ks], acc[1][rb], 0, 0, 0);
                    if (rb == 3) __builtin_amdgcn_sched_barrier(0); }
            float Hc = hin[d], TA = 1.f, TB = 0.f;
            const bool first1 = ((quad & 1) == d), firstp = (((quad >> 1) & 1) == d);
#pragma unroll
            for (int rbi = 0; rbi < 4; ++rbi) {
                const int rb = d ? 3 - rbi : rbi;
                __builtin_amdgcn_sched_barrier(0);
                float ea[4], eb[4];
#pragma unroll
                for (int j = 0; j < 4; ++j) { const int t = 16 * rb + 4 * quad + j;
                    const float r = fsigmoid(acc[0][rb][j] + ba_[d]), ig = fsigmoid(acc[1][rb][j] + bx_[d]), xv = bf2f(XCV[t * XCV_P + n]);
                    const float la = -8.0f * r * sp_[d], av = __builtin_amdgcn_exp2f(la * 1.4426950408889634f);
                    const float y = 2.0f * la;
                    const float ser = -y * (1.0f + y * (0.5f + y * (0.16666667f + y * (0.041666668f + y * 0.0083333338f))));
                    const float om = (y > -0.25f) ? ser : (1.0f - av * av);
                    ea[j] = av; eb[j] = __builtin_amdgcn_sqrtf(om) * (ig * xv); }
                float pA[4], pB[4];
                if (d == 0) { pA[0] = ea[0]; pB[0] = eb[0];
#pragma unroll
                    for (int j = 1; j < 4; ++j) { pA[j] = pA[j - 1] * ea[j]; pB[j] = ea[j] * pB[j - 1] + eb[j]; } }
                else { pA[3] = ea[3]; pB[3] = eb[3];
#pragma unroll
                    for (int j = 2; j >= 0; --j) { pA[j] = pA[j + 1] * ea[j]; pB[j] = ea[j] * pB[j + 1] + eb[j]; } }
                const float LA_ = d ? pA[0] : pA[3], LB_ = d ? pB[0] : pB[3];
                const float xA = __builtin_bit_cast(float, __builtin_amdgcn_ds_bpermute(p16, __builtin_bit_cast(int, LA_)));
                const float xB = __builtin_bit_cast(float, __builtin_amdgcn_ds_bpermute(p16, __builtin_bit_cast(int, LB_)));
                const float PTA = LA_ * xA, PTB = first1 ? (xA * LB_ + xB) : (LA_ * xB + LB_);
                float EA = first1 ? 1.f : xA, EB = first1 ? 0.f : xB;
                const float oA = __builtin_bit_cast(float, __builtin_amdgcn_ds_bpermute(p32, __builtin_bit_cast(int, PTA)));
                const float oB = __builtin_bit_cast(float, __builtin_amdgcn_ds_bpermute(p32, __builtin_bit_cast(int, PTB)));
                const float QA = PTA * oA, QB = firstp ? (oA * PTB + oB) : (PTA * oB + PTB);
                if (!firstp) { EB = EA * oB + EB; EA = oA * EA; }
                if (PASS3) {
                    const float hs = EA * Hc + EB;
#pragma unroll
                    for (int j = 0; j < 4; ++j) { const float hv = pA[j] * hs + pB[j];
                        if (d == 0) hf[rb][j] = hv;
                        else { const int t = 16 * rb + 4 * quad + j; GY[t * 128 + n] = (bf16)f2bf((hf[rb][j] + hv) * bf2f(GY[t * 128 + n])); } }
                    Hc = QA * Hc + QB;
                } else { TB = QA * TB + QB; TA = TA * QA; }
            }
            if (!PASS3) { if (quad == 0) AGG[((size_t)d * NCH + ch) * DLRU + h * 128 + n] = (f32x2){TA, TB}; }
        }
        if (PASS3) {
            __syncthreads();
#pragma unroll
            for (int rr = 0; rr < 2; ++rr) *(u32x4*)(ALRU + (size_t)(rowbase + p0 + tr + 32 * rr) * DLRU + cf) = *(const LAS u32x4*)(GY + (tr + 32 * rr) * 128 + c8 * 8);
        }
    }
}

__device__ __forceinline__ void phase_carry(KP a, int G) {
    int tid_ = threadIdx.x; asm volatile("" : "+v"(tid_)); const int tid = tid_;
    if (blockIdx.x >= 32 || tid >= 64) return;
    const int seq = blockIdx.x * 64 + tid, d = seq >> 10, cf = seq & 1023;
    const f32x2* AGG = (const f32x2*)(a->ws + OFF_AGG) + (size_t)d * NCH * DLRU + cf;
    float* CARRY = (float*)(a->ws + OFF_CARRY) + (size_t)d * NCH * DLRU + cf;
    float hh = 0.f;
    for (int s0 = 0; s0 < NCH; s0 += 20) {
        f32x2 ab[20]; int id[20];
#pragma unroll
        for (int j = 0; j < 20; ++j) { const int s = s0 + j; id[j] = (s < 4) ? 256 + (d ? 3 - s : s) : (d ? 255 - (s - 4) : s - 4); ab[j] = AGG[(size_t)id[j] * DLRU]; }
#pragma unroll
        for (int j = 0; j < 20; ++j) { CARRY[(size_t)id[j] * DLRU] = hh; hh = ab[j].x * hh + ab[j].y; }
    }
}
#ifndef PH_MASK
#define PH_MASK 0xFFFFF
#endif
#define EN(k) ((PH_MASK >> (k)) & 1)
#ifndef DUP_PH
#define DUP_PH -1
#endif
#ifndef DUP_SYNC
#define DUP_SYNC 0
#endif
#ifndef WGM_WIN
#define WGM_WIN 4
#endif
#ifndef WGM_MRG
#define WGM_MRG 4
#endif
#ifndef WGM_N8
#define WGM_N8 4
#endif
#ifndef WGM_FFI
#define WGM_FFI 4
#endif
constexpr int N_PHASES = 22;
__global__ void __launch_bounds__(NTHREADS, 2) mega(Args a_unused) {
    KP a = (KP)__builtin_amdgcn_kernarg_segment_ptr();
    extern __shared__ __attribute__((aligned(16))) unsigned char lds_raw[];
    LAS unsigned char* lds = (LAS unsigned char*)lds_raw;
    const int G = gridDim.x, bid = blockIdx.x;
    const int ph_lo = a->ph_lo, ph_hi = a->ph_hi;
    volatile LAS unsigned* MISC = (volatile LAS unsigned*)(lds + LDS_BYTES - 64);
    if (threadIdx.x < 2) MISC[threadIdx.x] = 0u;
    __syncthreads();
    const XcdBarrier bar = xcd_barrier_post((unsigned*)(a->ws + OFF_BAR), MISC);
    if (ph_lo < 0) cg::this_grid().sync();
    for (int vp = ph_lo; vp < ph_hi + (DUP_PH >= 0 ? 1 : 0); ++vp) {
      const int ph = (DUP_PH >= 0 && vp > DUP_PH) ? vp - 1 : vp;
      {
        asm volatile("" : "+s"(a));
        unsigned char* ws = a->ws;
        const float* MODS = (const float*)(ws + OFF_MODS);
        float* XC = (float*)(ws + OFF_XC);
        bf16* UB = (bf16*)(ws + OFF_UB); bf16* P = (bf16*)(ws + OFF_P); bf16* HB = (bf16*)(ws + OFF_P);
        if (ph == 0) { if (EN(10)) phase_prologue(a, lds, G); }
        else if (ph == N_PHASES - 1) { if (EN(11)) phase_final(a->out, a->norm_f_g, G); }
        else {
            const int l = (ph - 1) / 10, sp = (ph - 1) % 10;
            const unsigned char* wl = ws + OFF_W + (size_t)l * W_LAYER;
            const float* modx = MODS + (size_t)(l * 2 + 0) * 6 * D; const float* modc = MODS + (size_t)(l * 2 + 1) * 6 * D;
            const bool lastl = (l == 1);
            if (sp == 0 && EN(0)) { const bool first = (l == 0);
                phase_norm<4>(first ? a->x : a->out, XC, a->norm1_g + (size_t)l * D, modx, modc, 0, UB, 0, MT, bid * NWAVES, G * NWAVES, (const float*)(ws + OFF_PART), lastl ? 11 : 0); }
            else if (sp == 1 && EN(1)) { PlainSched S; S.T.init(64, DIN / 256, G, bid, WGM_WIN); S.A = (const char*)UB; S.B = (const char*)(wl + W_IN); S.pitchA = D * 2; S.pitchB = D * 2; S.nt = D / 64;
                S.extra = lastl ? 4 * 8 : DIN / 256; S.xn = lastl ? 4 : DIN / 256; S.xnt = lastl ? 4 : D / 64;
                EpiWin E{P, (bf16*)(ws + OFF_GT), a->b_gate + (size_t)l * 3 * D, (float*)(ws + OFF_PART)}; pg8::gemm_phase(lds, S, E);
                if (!lastl) { __syncthreads(); conv_range(a, 0, CR_FFI0, CR_G0, DIN / 256, G, lds); } }
            else if (sp == 2 && EN(2)) {
                if (EN(12)) { ChDftSched S{G, bid, (const char*)(ws + OFF_DCH), (const char*)P, 0}; EpiChDft<true> E{(bf16*)(ws + OFF_YT2), (bf16*)(ws + OFF_YC)}; pg8::gemm_phase(lds, S, E); }
                if (EN(12) && !lastl) { ChDftSched S{G, bid, (const char*)(ws + OFF_DCH), (const char*)P, 1}; EpiChDft<false> E{(bf16*)(ws + OFF_YT2), (bf16*)(ws + OFF_YC)}; pg8::gemm_phase(lds, S, E); }
                __syncthreads();
                if (EN(13)) phase_pool(P, (bf16*)(ws + OFF_PL), G, lastl ? L : MT);
                if (EN(14)) phase_lru3<false>(a, l, lds, G, NCH);
            }
            else if (sp == 3 && EN(3)) {
                phase_carry(a, G);
                __syncthreads();
                if (EN(12)) { FftASched S{G, bid, (const char*)(ws + OFF_DA), (const char*)(ws + OFF_YT2)}; EpiFftA E{(bf16*)(ws + OFF_ZT)}; pg8::gemm_phase(lds, S, E); }
            }
            else if (sp == 4 && EN(4)) { FftCSched S{G, bid, (const char*)(ws + OFF_E), (const char*)(ws + OFF_ZT), (const char*)(ws + OFF_DC), (const char*)(ws + OFF_YC), lastl ? 256 : 258};
                EpiFftC E{(bf16*)(ws + OFF_FO)}; pg8::gemm_phase(lds, S, E);
                __syncthreads();
                if (EN(14)) phase_lru3<true>(a, l, lds, G, lastl ? 256 : NCH); }
            else if (sp == 5 && EN(5)) { MergeSched S; S.T.init(lastl ? 64 : 65, D / 256, G, bid, WGM_MRG); S.ALRU = (const char*)(ws + OFF_ALRU); S.PL = (const char*)(ws + OFF_PL); S.FO = (const char*)(ws + OFF_FO);
                S.WLO = (const char*)(wl + W_LO); S.WPOOL = (const char*)(wl + W_POOL); S.WF = (const char*)(wl + W_F);
                EpiMerge E{UB, (const bf16*)(ws + OFF_GT), (bf16*)(ws + OFF_YT2), a->pool_scale + (size_t)l * D}; pg8::gemm_phase(lds, S, E);
                if (!lastl) { __syncthreads(); conv_range(a, 1, 0, CI_IN, 8, G, lds); } }
            else if (sp == 6 && EN(6)) { PlainSched S; S.T.init(64, D / 256, G, bid, WGM_N8); S.A = (const char*)UB; S.B = (const char*)(wl + W_OUT); S.pitchA = D * 2; S.pitchB = D * 2; S.nt = D / 64;
                S.extra = lastl ? 0 : 8 * 8; S.xn = 8; S.xnt = 4;
                const bool first = (l == 0);
                EpiRes E{first ? a->x : a->out, a->out, XC, XC, modx + 2 * D, modc + 2 * D, (float*)(ws + OFF_PART)}; pg8::gemm_phase(lds, S, E); }
            else if (sp == 7 && EN(7)) phase_norm<4>(a->out, XC, a->norm2_g + (size_t)l * D, modx, modc, 3, UB, 0, lastl ? L : MT, bid * NWAVES, G * NWAVES, (const float*)(ws + OFF_PART), 8);
            else if (sp == 8 && EN(8)) { PlainSched S; S.T.init(64, 2 * DFF / 256, G, bid, WGM_FFI); S.A = (const char*)UB; S.B = (const char*)(wl + W_FFI); S.pitchA = D * 2; S.pitchB = D * 2; S.nt = D / 64;
                S.extra = lastl ? 0 : 2 * DFF / 256; S.xn = 2 * DFF / 256; S.xnt = D / 64;
                EpiFfi E{HB}; pg8::gemm_phase(lds, S, E);
                if (!lastl) { __syncthreads(); conv_range(a, 1, CI_IN, CI_LAYER, 2 * DFF / 256, G, lds); } }
            else if (EN(9)) { PlainSched S; S.T.init(64, D / 256, G, bid, WGM_N8); S.A = (const char*)HB; S.B = (const char*)(wl + W_FFO); S.pitchA = DFF * 2; S.pitchB = DFF * 2; S.nt = DFF / 64;
                S.extra = lastl ? 0 : 8 * 11; S.xn = 8; S.xnt = 8;
                EpiRes E{a->out, a->out, XC, XC, modx + 5 * D, modc + 5 * D, (float*)(ws + OFF_PART)}; pg8::gemm_phase(lds, S, E); }
        }
      }
        if (vp + 1 < ph_hi + (DUP_PH >= 0 ? 1 : 0)) { xcd_barrier(bar); if (DUP_SYNC) xcd_barrier(bar); }
    }
}

extern "C" void kernel_launch(void* const* d_in, const int* in_sizes, int n_in, void* d_out, int out_size, void* d_ws, size_t ws_size, hipStream_t stream) {
    static int grid = 0;
    if (grid == 0) {
        if (n_in != 25 || out_size != L * D || ws_size < WS_END) { fprintf(stderr, "kernel_launch: unexpected shapes (n_in %d out %d ws %zu need %zu)\n", n_in, out_size, ws_size, (size_t)WS_END); grid = -1; return; }
        int dev = 0, cus = 0, per_cu = 0;
        hipGetDevice(&dev); hipDeviceGetAttribute(&cus, hipDeviceAttributeMultiprocessorCount, dev);
        if (hipFuncSetAttribute((const void*)mega, hipFuncAttributeMaxDynamicSharedMemorySize, LDS_BYTES) != hipSuccess) { fprintf(stderr, "kernel_launch: hipFuncSetAttribute failed\n"); grid = -1; return; }
        hipOccupancyMaxActiveBlocksPerMultiprocessor(&per_cu, (const void*)mega, NTHREADS, LDS_BYTES);
        (void)hipGetLastError();
        if (per_cu < 1) per_cu = 1;
        grid = cus * 1;
        if (grid <= 0) grid = 256;
    }
    if (grid < 0) return;
    if (hipMemsetAsync((char*)d_ws + OFF_BAR, 0, BAR_BYTES, stream) != hipSuccess) { fprintf(stderr, "kernel_launch: memset failed\n"); return; }
    Args a{};
    const float** pp = (const float**)&a;
    for (int i = 0; i < 25; ++i) pp[i] = (const float*)d_in[i];
    a.out = (float*)d_out; a.ws = (unsigned char*)d_ws;
#if N_LAUNCH_MODE == 1
    a.ph_lo = 0; a.ph_hi = N_PHASES;
    void* args[] = {&a};
    hipError_t e = hipLaunchCooperativeKernel((const void*)mega, dim3(grid), dim3(NTHREADS), args, LDS_BYTES, stream);
    if (e != hipSuccess) fprintf(stderr, "cooperative launch failed: %s (grid %d)\n", hipGetErrorString(e), grid);
#else
    for (int ph = 0; ph < N_PHASES; ++ph) { a.ph_lo = ph; a.ph_hi = ph + 1; hipLaunchKernelGGL(mega, dim3(grid), dim3(NTHREADS), LDS_BYTES, stream, a); }
#endif
}
```

```cpp
#include <hip/hip_runtime.h>
#include <hip/hip_cooperative_groups.h>
#include <cstdio>
#include <cstdint>
namespace cg = cooperative_groups;

#ifndef N_LAUNCH_MODE
#define N_LAUNCH_MODE 1
#endif

#define LAS __attribute__((address_space(3)))
typedef unsigned short bf16;
typedef short bf16x8 __attribute__((ext_vector_type(8)));
typedef float f32x4 __attribute__((ext_vector_type(4)));
typedef float f32x2 __attribute__((ext_vector_type(2)));
typedef unsigned u32x4 __attribute__((ext_vector_type(4)));
typedef unsigned u32x2 __attribute__((ext_vector_type(2)));

constexpr int D = 2048, L = 16384, LC = 256, MT = L + LC;
constexpr int DIN = 9216, DFF = 5632, DLRU = 1024, DP = 512, DFO = 512;
constexpr int PP = 3072;
constexpr int I_YA = 1024, I_XB = 2048, I_XC = 2560, I_G = 3072;
constexpr int NCH = MT / 64;
constexpr float NORM_EPS = 1e-6f;
constexpr int NTHREADS = 512, NWAVES = 8;
constexpr int LDS_BYTES = 147456;

constexpr size_t KiB = 1024, MiB = 1024 * 1024;
constexpr size_t OFF_MODS = 0;
constexpr size_t OFF_DCH = 256 * KiB;
constexpr size_t OFF_DA = 320 * KiB;
constexpr size_t OFF_DC = 448 * KiB;
constexpr size_t OFF_E = 1 * MiB;
constexpr size_t OFF_XC = 10 * MiB;
constexpr size_t OFF_AGG = 12 * MiB;
constexpr size_t OFF_YC = 17 * MiB;
constexpr size_t OFF_BAR = 17 * MiB + 512 * KiB;
constexpr size_t BAR_BYTES = 16 * KiB;
constexpr size_t OFF_CARRY = 18 * MiB;
constexpr size_t OFF_W = 21 * MiB;
constexpr size_t W_IN = 0, W_LO = W_IN + (size_t)DIN * D * 2, W_POOL = W_LO + (size_t)D * DLRU * 2, W_F = W_POOL + (size_t)D * 128 * 2,
                 W_OUT = W_F + (size_t)D * DFO * 2, W_FFI = W_OUT + (size_t)D * D * 2, W_FFO = W_FFI + (size_t)2 * DFF * D * 2,
                 W_G = W_FFO + (size_t)D * DFF * 2, W_LAYER = 118 * MiB;
static_assert(W_G + 32 * 16384 * 2 <= W_LAYER, "weights");
constexpr size_t OFF_UB = OFF_W + 2 * W_LAYER;
constexpr size_t OFF_P = OFF_UB + 65 * MiB;
constexpr size_t OFF_GT = OFF_P + 98 * MiB;
constexpr size_t OFF_ALRU = OFF_P + 293 * MiB;
constexpr size_t OFF_PL = OFF_ALRU + 33 * MiB;
constexpr size_t OFF_YT2 = OFF_PL + 17 * MiB;
constexpr size_t OFF_ZT = OFF_YT2 + 32 * MiB;
constexpr size_t OFF_FO = OFF_ZT + 32 * MiB;
constexpr size_t OFF_PART = OFF_FO + 17 * MiB;
constexpr size_t WS_END = OFF_PART + 22 * MiB;
static_assert((size_t)MT * D * 2 <= 65 * MiB && (size_t)MT * PP * 2 <= 98 * MiB && (size_t)MT * 6144 * 2 <= 195 * MiB && (size_t)MT * DFF * 2 <= 293 * MiB && (size_t)MT * 1024 * 2 <= 33 * MiB && (size_t)MT * 512 * 2 <= 17 * MiB, "map");

__device__ __forceinline__ unsigned f2bf(float f) { unsigned u = __builtin_bit_cast(unsigned, f); return (u + 0x7fffu + ((u >> 16) & 1u)) >> 16; }
__device__ __forceinline__ unsigned pk2(float lo, float hi) { return f2bf(lo) | (f2bf(hi) << 16); }
__device__ __forceinline__ float bf2f(unsigned short b) { return __builtin_bit_cast(float, (unsigned)b << 16); }
__device__ __forceinline__ float bflo(unsigned w) { return __builtin_bit_cast(float, w << 16); }
__device__ __forceinline__ float bfhi(unsigned w) { return __builtin_bit_cast(float, w & 0xffff0000u); }
__device__ __forceinline__ float sigmoidf_(float z) { return __builtin_amdgcn_rcpf(1.0f + __builtin_amdgcn_exp2f(-1.4426950408889634f * z)); }
__device__ __forceinline__ float fsigmoid(float z) { return __builtin_amdgcn_rcpf(1.0f + __builtin_amdgcn_exp2f(-1.4426950408889634f * z)); }
__device__ __forceinline__ float softplus_neg(float lam) {
    if (-lam > 20.f) return -lam;
    const float x = __expf(-lam);
    return x < 0.05f ? x * (1.0f - x * (0.5f - x * (0.33333334f - x * (0.25f - x * 0.2f)))) : __logf(1.0f + x);
}
__device__ __forceinline__ float siluf_(float z) { return z * sigmoidf_(z); }
__device__ __forceinline__ float gelu_tanh(float v) { const float u = 1.5957691216f * (v + 0.044715f * v * v * v); return v * sigmoidf_(u); }
__device__ __forceinline__ float wave_sum(float v, int lane) {
#pragma unroll
    for (int o = 1; o < 64; o <<= 1) v += __builtin_bit_cast(float, __builtin_amdgcn_ds_bpermute((lane ^ o) << 2, __builtin_bit_cast(int, v)));
    return v;
}


#define XB_TMO      128
#define XB_XCNT(j)  (256  + 64 * (j))
#define XB_XSUB(j)  (1280 + 64 * (j))
#define XB_XGEN(j)  (2304 + 64 * (j))
#define XB_TOP      3328
#define XB_TOPGEN   3392
#define XCD_BAR_WORDS 3456
#define XB_SPIN_CAP (1u << 18)
__device__ __forceinline__ unsigned xb_ld(unsigned* p)              { return __hip_atomic_load(p, __ATOMIC_RELAXED, __HIP_MEMORY_SCOPE_AGENT); }
__device__ __forceinline__ unsigned xb_add(unsigned* p, unsigned v) { return __hip_atomic_fetch_add(p, v, __ATOMIC_RELAXED, __HIP_MEMORY_SCOPE_AGENT); }
__device__ __forceinline__ unsigned xb_xcc_id() { return (unsigned)__builtin_amdgcn_s_getreg((3 << 11) | 20) & 0xFu; }
#define XB_SPIN(cond, bar) do { unsigned _sp = 0; while (cond) { __builtin_amdgcn_s_sleep(1); \
    if ((++_sp & 255u) == 0u) { if (xb_ld(&(bar)[XB_TMO])) break; if (_sp > XB_SPIN_CAP) { atomicAdd(&(bar)[XB_TMO], 1u); break; } } } } while (0)
struct XcdBarrier { unsigned* bar; unsigned x; volatile LAS unsigned* st; };
__device__ __forceinline__ XcdBarrier xcd_barrier_post(unsigned* bar, volatile LAS unsigned* st) {
    XcdBarrier b; b.bar = bar; b.x = xb_xcc_id(); b.st = st;
    if (threadIdx.x == 0) (void)xb_add(&bar[XB_XCNT(b.x)], 1u);
    return b;
}
__device__ __forceinline__ void xcd_barrier_complete(unsigned* bar, unsigned x, unsigned& nloc, unsigned& nx) {
    const unsigned G = gridDim.x * gridDim.y * gridDim.z;
    unsigned sum, cnt, mine, sp = 0u;
    for (;;) {
        sum = 0u; cnt = 0u; mine = 0u;
#pragma unroll
        for (unsigned j = 0; j < 16; ++j) { const unsigned c = xb_ld(&bar[XB_XCNT(j)]); sum += c; cnt += (c > 0u) ? 1u : 0u; mine = (j == x) ? c : mine; }
        if (sum == G) break;
        __builtin_amdgcn_s_sleep(1);
        if ((++sp & 255u) == 0u) { if (xb_ld(&bar[XB_TMO])) break; if (sp > XB_SPIN_CAP) { atomicAdd(&bar[XB_TMO], 1u); break; } }
    }
    nloc = mine > 0u ? mine : 1u; nx = cnt > 0u ? cnt : 1u;
}
__device__ __forceinline__ void xcd_barrier(const XcdBarrier& b) {
    asm volatile("s_waitcnt vmcnt(0)" ::: "memory");
    __syncthreads();
    if (threadIdx.x == 0) {
        unsigned* bar = b.bar;
        __builtin_amdgcn_s_waitcnt(0);
        unsigned nloc = b.st[0], nx = b.st[1];
        if (nloc == 0u) { xcd_barrier_complete(bar, b.x, nloc, nx); b.st[0] = nloc; b.st[1] = nx; }
        const unsigned old = xb_add(&bar[XB_XSUB(b.x)], 1u);
        const unsigned gen = old / nloc;
        if (old + 1u == (gen + 1u) * nloc) {
            __builtin_amdgcn_fence(__ATOMIC_RELEASE, "agent");
            asm volatile("s_waitcnt vmcnt(0)" ::: "memory");
            const unsigned og = xb_add(&bar[XB_TOP], 1u);
            const unsigned tg = og / nx;
            if (og + 1u == (tg + 1u) * nx) xb_add(&bar[XB_TOPGEN], 1u);
            else XB_SPIN(xb_ld(&bar[XB_TOPGEN]) == tg, bar);
            __builtin_amdgcn_fence(__ATOMIC_ACQUIRE, "agent");
            xb_add(&bar[XB_XGEN(b.x)], 1u);
            asm volatile("s_waitcnt vmcnt(0)" ::: "memory");
        } else {
            XB_SPIN(xb_ld(&bar[XB_XGEN(b.x)]) == gen, bar);
            __builtin_amdgcn_fence(__ATOMIC_ACQUIRE, "agent");
            asm volatile("s_waitcnt vmcnt(0)" ::: "memory");
        }
    }
    __syncthreads();
}

#ifndef PG8_ALIGN_EPI
#define PG8_ALIGN_EPI 1
#endif
namespace pg8 {
#define PG8_LAS __attribute__((address_space(3)))
constexpr int BM = 256, BK = 64, HALF = 128, HTB = HALF * BK * 2, STAGE_BYTES = 8 * HTB, NXCD = 8, WGM = 8;
__host__ __device__ __forceinline__ int lds_byte(int r, int c) { const int st = (r >> 4) * 2 + (c >> 5), rr = r & 15, cc = c & 31, ob = rr * 64 + cc * 2; return st * 1024 + (ob ^ (((ob >> 9) & 1) << 5)); }
__host__ __device__ __forceinline__ void stage_rc(int b, int& R, int& C) { const int st = b / 1024, sb = b % 1024, swz = sb ^ (((sb >> 9) & 1) << 5); R = (st >> 1) * 16 + swz / 64; C = (st & 1) * 32 + (swz % 64) / 2; }
__host__ __device__ __forceinline__ int perm32(int rho) { const int n = rho >> 4, i = rho & 15; return 8 * (i >> 2) + 4 * n + (i & 3); }

struct Unit { const char* A0; const char* A1; const char* B0; const char* B1; unsigned pitchA, pitchB; int nt; int pm, pn, aux; };

struct TileOrder {
    int nM, nN, nwg, G, c, WGMv;
    __device__ void init(int nM_, int nN_, int G_, int c_, int wgm_) { nM = nM_; nN = nN_; nwg = nM * nN; G = G_; c = c_; WGMv = wgm_; }
    __device__ bool get(int i, int& pm, int& pn) const {
        const long Lq = (long)i * G + c; if (Lq >= nwg) return false;
        int wgid = (int)Lq; { const int q = nwg / NXCD, r = nwg % NXCD, xcd = wgid % NXCD, off = wgid / NXCD; wgid = (xcd < r ? xcd * (q + 1) : r * (q + 1) + (xcd - r) * q) + off; }
        const int nig = WGMv * nN, gid = wgid / nig, fm = gid * WGMv, gsz = (nM - fm) < WGMv ? (nM - fm) : WGMv;
        pm = fm + ((wgid % nig) % gsz); pn = (wgid % nig) / gsz; return true;
    }
};

template <class Epi, class Sched>
__device__ __forceinline__ void gemm_phase(PG8_LAS unsigned char* lds, const Sched& S, const Epi& E) {
    int tid_ = threadIdx.x; asm volatile("" : "+v"(tid_)); const int tid = tid_, wid = __builtin_amdgcn_readfirstlane(tid >> 6), lane = tid & 63, wr = wid >> 2, wc = wid & 3, fr = lane & 15, fq = lane >> 4;
    unsigned rA0, rB0, cO0;
    { int R, C; stage_rc(tid * 16, R, C); rA0 = (unsigned)R; rB0 = (unsigned)(Epi::PERM ? ((R & ~31) + perm32(R & 31)) : R); cO0 = (unsigned)C * 2u; }
    const size_t kstep = (size_t)(BK * 2);
    const unsigned ldsw = (unsigned)wid * 1024u;
    const int aoff = lds_byte(wr * 64 + fr, fq * 8), boff = lds_byte(wc * 32 + fr, fq * 8);
#define PG8_SA(b, h) (((b) * 2 + (h)) * HTB)
#define PG8_SB(b, h) ((4 + (b) * 2 + (h)) * HTB)
#define PG8_STAGE(bufoff, gbase, voff, pitch) do { const char* _g0 = (const char*)(gbase); const char* _g1 = _g0 + (size_t)(pitch) * 64; asm volatile("" : "+s"(_g0), "+s"(_g1)); \
        __builtin_amdgcn_global_load_lds((const unsigned*)(_g0 + (voff)), (PG8_LAS unsigned*)(lds + (bufoff) + ldsw), 16, 0, 0); \
        __builtin_amdgcn_global_load_lds((const unsigned*)(_g1 + (voff)), (PG8_LAS unsigned*)(lds + (bufoff) + ldsw + 8192), 16, 0, 0); } while (0)
#define PG8_LDA(dst, b, h) do { _Pragma("unroll") for (int m = 0; m < 4; ++m) _Pragma("unroll") for (int k = 0; k < 2; ++k) dst[m][k] = *(const PG8_LAS bf16x8*)(lds + PG8_SA(b, h) + aoff + m * 2048 + k * 1024); } while (0)
#define PG8_LDB(dst, b, h) do { _Pragma("unroll") for (int n = 0; n < 2; ++n) _Pragma("unroll") for (int k = 0; k < 2; ++k) dst[n][k] = *(const PG8_LAS bf16x8*)(lds + PG8_SB(b, h) + boff + n * 2048 + k * 1024); } while (0)
#define PG8_MMA(ai, bj, At, Bt) do { __builtin_amdgcn_s_setprio(1); _Pragma("unroll") for (int m = 0; m < 4; ++m) _Pragma("unroll") for (int n = 0; n < 2; ++n) _Pragma("unroll") for (int k = 0; k < 2; ++k) \
        acc[ai][bj][m][n] = __builtin_amdgcn_mfma_f32_16x16x32_bf16(Bt[n][k], At[m][k], acc[ai][bj][m][n], 0, 0, 0); __builtin_amdgcn_s_setprio(0); } while (0)
#define PG8_WAIT_V(n) asm volatile("s_waitcnt vmcnt(" #n ")" ::: "memory")
#define PG8_WAIT_L(n) asm volatile("s_waitcnt lgkmcnt(" #n ")" ::: "memory")
#define PG8_BAR __builtin_amdgcn_s_barrier()
#define PG8_SCHED __builtin_amdgcn_sched_barrier(0)
    Unit cur, nxt; int ui = 0;
    if (!S.next(0, cur)) return;
    f32x4 acc[2][2][4][2];
#pragma unroll
    for (int a = 0; a < 2; ++a)
#pragma unroll
        for (int b = 0; b < 2; ++b)
#pragma unroll
            for (int m = 0; m < 4; ++m)
#pragma unroll
                for (int n = 0; n < 2; ++n) acc[a][b][m][n] = (f32x4){0.f, 0.f, 0.f, 0.f};
    bf16x8 At[4][2], B0[2][2], B1[2][2];
    unsigned vAc = rA0 * cur.pitchA + cO0, vBc = rB0 * cur.pitchB + cO0, vAn, vBn;
    PG8_STAGE(PG8_SB(0, 0), cur.B0, vBc, cur.pitchB); PG8_STAGE(PG8_SB(0, 1), cur.B1, vBc, cur.pitchB); PG8_STAGE(PG8_SA(0, 0), cur.A0, vAc, cur.pitchA); PG8_STAGE(PG8_SA(0, 1), cur.A1, vAc, cur.pitchA);
    if (wr == 1) PG8_BAR;
    PG8_WAIT_V(2); PG8_BAR;
    PG8_STAGE(PG8_SB(1, 0), cur.B0 + kstep, vBc, cur.pitchB); PG8_STAGE(PG8_SA(1, 0), cur.A0 + kstep, vAc, cur.pitchA); PG8_STAGE(PG8_SB(1, 1), cur.B1 + kstep, vBc, cur.pitchB);
    PG8_WAIT_V(6); PG8_BAR;
    for (;;) {
        const bool has_next = S.next(ui + 1, nxt);
        if (!has_next) nxt = cur;
        { int t2 = tid; asm volatile("" : "+v"(t2)); int R, C; stage_rc(t2 * 16, R, C);
          const unsigned rb = (unsigned)(Epi::PERM ? ((R & ~31) + perm32(R & 31)) : R);
          vAn = (unsigned)R * nxt.pitchA + (unsigned)C * 2u; vBn = rb * nxt.pitchB + (unsigned)C * 2u; }
        const int nt = cur.nt;
        for (int t = 0; t < nt; t += 2) {
            const bool last = (t == nt - 2);
            const char* a1_1 = cur.A1 + (size_t)(t + 1) * kstep;
            const char* a2_0 = last ? nxt.A0 : cur.A0 + (size_t)(t + 2) * kstep; const char* a2_1 = last ? nxt.A1 : cur.A1 + (size_t)(t + 2) * kstep;
            const char* b2_0 = last ? nxt.B0 : cur.B0 + (size_t)(t + 2) * kstep; const char* b2_1 = last ? nxt.B1 : cur.B1 + (size_t)(t + 2) * kstep;
            const unsigned vA2 = last ? vAn : vAc, vB2 = last ? vBn : vBc, pA2 = last ? nxt.pitchA : cur.pitchA, pB2 = last ? nxt.pitchB : cur.pitchB;
            PG8_LDB(B0, 0, 0); PG8_LDB(B1, 0, 1); PG8_SCHED; PG8_LDA(At, 0, 0); PG8_STAGE(PG8_SA(1, 1), a1_1, vAc, cur.pitchA);
            PG8_WAIT_V(8); PG8_WAIT_L(0); PG8_BAR; PG8_MMA(0, 0, At, B0); PG8_MMA(0, 1, At, B1); PG8_BAR; PG8_SCHED;
            PG8_LDA(At, 0, 1); PG8_STAGE(PG8_SB(0, 0), b2_0, vB2, pB2); PG8_STAGE(PG8_SB(0, 1), b2_1, vB2, pB2); PG8_STAGE(PG8_SA(0, 0), a2_0, vA2, pA2);
            PG8_WAIT_V(8); PG8_WAIT_L(0); PG8_BAR; PG8_MMA(1, 0, At, B0); PG8_MMA(1, 1, At, B1); PG8_BAR; PG8_SCHED;
            PG8_LDB(B0, 1, 0); PG8_LDB(B1, 1, 1); PG8_SCHED; PG8_LDA(At, 1, 0); PG8_STAGE(PG8_SA(0, 1), a2_1, vA2, pA2);
            PG8_WAIT_V(8); PG8_WAIT_L(0); PG8_BAR; PG8_MMA(0, 0, At, B0); PG8_MMA(0, 1, At, B1); PG8_BAR; PG8_SCHED;
            PG8_LDA(At, 1, 1); PG8_STAGE(PG8_SB(1, 0), b2_0 + kstep, vB2, pB2); PG8_STAGE(PG8_SB(1, 1), b2_1 + kstep, vB2, pB2); PG8_STAGE(PG8_SA(1, 0), a2_0 + kstep, vA2, pA2);
            PG8_WAIT_V(8); PG8_WAIT_L(0); PG8_BAR; PG8_MMA(1, 0, At, B0); PG8_MMA(1, 1, At, B1); PG8_BAR; PG8_SCHED;
        }
        if (PG8_ALIGN_EPI) { if (wr == 0) PG8_BAR; }
        { int l2 = lane; asm volatile("" : "+v"(l2)); E(acc, cur, wr, wc, l2 & 15, l2 >> 4); }
        if (!has_next) break;
#pragma unroll
        for (int a = 0; a < 2; ++a)
#pragma unroll
            for (int b = 0; b < 2; ++b)
#pragma unroll
                for (int m = 0; m < 4; ++m)
#pragma unroll
                    for (int n = 0; n < 2; ++n) acc[a][b][m][n] = (f32x4){0.f, 0.f, 0.f, 0.f};
        cur = nxt; ++ui;
        vAc = vAn; vBc = vBn;
        if (PG8_ALIGN_EPI) { if (wr == 1) PG8_BAR; }
    }
    PG8_WAIT_V(0);
    if (!PG8_ALIGN_EPI) { if (wr == 0) PG8_BAR; }
    PG8_BAR;
#undef PG8_SA
#undef PG8_SB
#undef PG8_STAGE
#undef PG8_LDA
#undef PG8_LDB
#undef PG8_MMA
#undef PG8_WAIT_V
#undef PG8_WAIT_L
#undef PG8_BAR
#undef PG8_SCHED
}
}
using pg8::Unit;

struct Args {
    const float *x, *c, *ctx, *c_ctx, *w_ada, *b_ada, *norm1_g, *norm2_g, *w_in, *conv_w, *conv_b, *lru_wa, *lru_ba, *lru_wx, *lru_bx, *lru_lambda,
        *w_lru_out, *w_pool, *pool_scale, *w_fourier, *b_gate, *w_out, *w_ffn_in, *w_ffn_out, *norm_f_g;
    float* out; unsigned char* ws; int ph_lo, ph_hi;
};

typedef const __attribute__((address_space(4))) Args* KP;
struct PlainSched {
    pg8::TileOrder T; const char* A; const char* B; unsigned pitchA, pitchB; int nt;
    int extra, xn, xnt;
    __device__ bool next(int i, Unit& u) const {
        int pm, pn; int ks = 0, nt_ = nt, aux = 0;
        if (!T.get(i, pm, pn)) { const int e = i * T.G + T.c - T.nwg; if (e >= extra) return false; pm = 64; pn = e % xn; ks = e / xn; nt_ = xnt; aux = (xnt != nt) ? 1 + ks : 0; }
        u.A0 = A + (size_t)pm * 256 * pitchA + (size_t)ks * xnt * 128; u.A1 = u.A0 + (size_t)128 * pitchA; u.B0 = B + (size_t)pn * 256 * pitchB + (size_t)ks * xnt * 128; u.B1 = u.B0 + (size_t)128 * pitchB;
        u.pitchA = pitchA; u.pitchB = pitchB; u.nt = nt_; u.pm = pm; u.pn = pn; u.aux = aux; return true;
    }
};
struct MergeSched {
    pg8::TileOrder T; const char *ALRU, *PL, *FO, *WLO, *WPOOL, *WF;
    __device__ bool next(int i, Unit& u) const {
        int pm, pn; const int ti = i / 3, pass = i - 3 * ti; if (!T.get(ti, pm, pn)) return false;
        if (pass == 0) { u.pitchA = DLRU * 2; u.pitchB = DLRU * 2; u.nt = DLRU / 64; u.A0 = ALRU + (size_t)pm * 256 * u.pitchA; u.B0 = WLO + (size_t)pn * 256 * u.pitchB; }
        else if (pass == 1) { u.pitchA = DP * 2; u.pitchB = 128 * 2; u.nt = 2; u.A0 = PL + (size_t)pm * 256 * u.pitchA + (size_t)(pn >> 1) * 128 * 2; u.B0 = WPOOL + (size_t)pn * 256 * u.pitchB; }
        else { u.pitchA = DFO * 2; u.pitchB = DFO * 2; u.nt = DFO / 64; u.A0 = FO + (size_t)pm * 256 * u.pitchA; u.B0 = WF + (size_t)pn * 256 * u.pitchB; }
        u.A1 = u.A0 + (size_t)128 * u.pitchA; u.B1 = u.B0 + (size_t)128 * u.pitchB; u.pm = pm; u.pn = pn; u.aux = pass; return true;
    }
};
struct ChDftSched {
    int G, c; const char *DCH, *P; int isctx;
    __device__ bool next(int i, Unit& u) const {
        const int Lq = i * G + c; if (Lq >= (isctx ? 4 : 256)) return false;
        const int T = isctx ? 64 : (Lq & 63), g = isctx ? Lq : (Lq >> 6);
        u.A0 = DCH; u.A1 = DCH + 128 * 256; u.pitchA = 256; u.nt = 2;
        if (T < 64) { u.B0 = P + ((size_t)(2 * T) * PP + I_XC + g * 128) * 2; u.B1 = u.B0 + (size_t)PP * 2; u.pitchB = 128u * PP * 2u; }
        else { u.B0 = P + ((size_t)L * PP + I_XC + g * 128) * 2; u.pitchB = PP * 2; u.B1 = u.B0 + (size_t)128 * PP * 2; }
        u.pm = T; u.pn = g; u.aux = 0; return true;
    }
};
struct FftASched {
    int G, c; const char *DA, *YT2;
    __device__ bool next(int i, Unit& u) const {
        const int Lq = i * G + c; if (Lq >= 256) return false;
        u.A0 = DA; u.A1 = DA + 128 * 512; u.pitchA = 512; u.nt = 4;
        u.B0 = YT2 + (size_t)Lq * 256 * 512; u.B1 = u.B0 + 128 * 512; u.pitchB = 512; u.pm = Lq; u.pn = 0; u.aux = 0; return true;
    }
};
struct FftCSched {
    int G, c; const char *E, *ZT, *DC, *YC; int nU;
    __device__ bool next(int i, Unit& u) const {
        const int Lq = i * G + c; if (Lq >= nU) return false;
        if (Lq < 256) { const int k1 = Lq >> 1, ch = Lq & 1;
            u.A0 = E + (size_t)k1 * 128 * 512; u.A1 = u.A0 + 128 * 512; u.pitchA = 512; u.nt = 4;
            u.B0 = ZT + ((size_t)k1 * 512 + ch * 256) * 512; u.B1 = u.B0 + 128 * 512; u.pitchB = 512; u.pm = k1; u.pn = ch; u.aux = 0; }
        else { const int ch = Lq - 256;
            u.A0 = DC; u.A1 = DC + 128 * 1024; u.pitchA = 1024; u.nt = 8;
            u.B0 = YC + (size_t)ch * 256 * 1024; u.B1 = u.B0 + 128 * 1024; u.pitchB = 1024; u.pm = 0; u.pn = ch; u.aux = 1; }
        return true;
    }
};

struct EpiWin {
    static constexpr bool PERM = true;
    bf16* P; bf16* GT; const float* b_gate; float* XA1;
    __device__ __forceinline__ void operator()(const f32x4 (&acc)[2][2][4][2], const Unit& u, int wr, int wc, int fr, int fq) const {
        const int row0 = u.pm * 256 + wr * 64 + fr, col0 = u.pn * 256 + wc * 32 + 8 * fq;
        if (u.aux) {
#pragma unroll
            for (int bj = 0; bj < 2; ++bj)
#pragma unroll
                for (int ai = 0; ai < 2; ++ai)
#pragma unroll
                    for (int m = 0; m < 4; ++m) { float* o = XA1 + (size_t)(u.aux - 1) * LC * DLRU + (size_t)(wr * 64 + fr + ai * 128 + m * 16) * DLRU + col0 + bj * 128;
                        *(f32x4*)o = acc[ai][bj][m][0]; *(f32x4*)(o + 4) = acc[ai][bj][m][1]; }
            return;
        }
        const int tid = (wr * 4 + wc) * 64 + fq * 16 + fr;
        bf16* gt = GT + ((size_t)(u.pm * 24 + (u.pn - 12)) * 16 * 512 + tid) * 8;
        const int mode = (u.pn >= 12) ? 2 : ((u.pn >= 4 && u.pn < 8) ? 1 : 0);
#pragma unroll
        for (int bj = 0; bj < 2; ++bj) {
            f32x4 b0 = (f32x4){0.f, 0.f, 0.f, 0.f}, b1 = b0;
            if (mode == 2) { b0 = *(const f32x4*)(b_gate + col0 + bj * 128 - I_G); b1 = *(const f32x4*)(b_gate + col0 + bj * 128 - I_G + 4); }
#pragma unroll
            for (int ai = 0; ai < 2; ++ai)
#pragma unroll
                for (int m = 0; m < 4; ++m) {
                    f32x4 v0 = acc[ai][bj][m][0] + b0, v1 = acc[ai][bj][m][1] + b1;
                    if (mode == 1) { for (int j = 0; j < 4; ++j) { v0[j] = gelu_tanh(v0[j]); v1[j] = gelu_tanh(v1[j]); } }
                    else if (mode == 2) { for (int j = 0; j < 4; ++j) { v0[j] = sigmoidf_(v0[j]); v1[j] = sigmoidf_(v1[j]); } }
                    u32x4 w; w.x = pk2(v0[0], v0[1]); w.y = pk2(v0[2], v0[3]); w.z = pk2(v1[0], v1[1]); w.w = pk2(v1[2], v1[3]);
                    if (mode == 2) *(u32x4*)(gt + ((ai * 4 + m) * 2 + bj) * 4096) = w;
                    else *(u32x4*)(P + (size_t)(row0 + ai * 128 + m * 16) * PP + col0 + bj * 128) = w;
                }
        }
    }
};
struct EpiRes {
    static constexpr bool PERM = false;
    const float* resx; float* outx; const float* resc; float* outc; const float* gx; const float* gc; float* part;
    __device__ __forceinline__ void operator()(const f32x4 (&acc)[2][2][4][2], const Unit& u, int wr, int wc, int fr, int fq) const {
        const bool isc = (u.pm == 64);
        const float* res = isc ? resc : resx; float* out = isc ? outc : outx; const float* g = isc ? gc : gx;
        const int row0 = (isc ? 0 : u.pm * 256) + wr * 64 + fr, col0 = u.pn * 256 + wc * 32 + 4 * fq;
#pragma unroll
        for (int bj = 0; bj < 2; ++bj)
#pragma unroll
            for (int n = 0; n < 2; ++n) {
                const int col = col0 + bj * 128 + 16 * n; const f32x4 gv = *(const f32x4*)(g + col);
                if (u.aux) {
#pragma unroll
                    for (int q = 0; q < 8; ++q) { const size_t o = (size_t)(u.aux - 1) * LC * D + (size_t)(row0 + (q >> 2) * 128 + (q & 3) * 16) * D + col; *(f32x4*)(part + o) = gv * acc[q >> 2][bj][q & 3][n]; }
                } else {
                    f32x4 r[8];
#pragma unroll
                    for (int q = 0; q < 8; ++q) r[q] = *(const f32x4*)(res + (size_t)(row0 + (q >> 2) * 128 + (q & 3) * 16) * D + col);
#pragma unroll
                    for (int q = 0; q < 8; ++q) __builtin_nontemporal_store(r[q] + gv * acc[q >> 2][bj][q & 3][n], (f32x4*)(out + (size_t)(row0 + (q >> 2) * 128 + (q & 3) * 16) * D + col));
                }
            }
    }
};
struct EpiFfi {
    static constexpr bool PERM = true;
    bf16* H;
    __device__ __forceinline__ void operator()(const f32x4 (&acc)[2][2][4][2], const Unit& u, int wr, int wc, int fr, int fq) const {
        const int row0 = u.pm * 256 + wr * 64 + fr, col0 = u.pn * 128 + wc * 32 + 8 * fq;
#pragma unroll
        for (int ai = 0; ai < 2; ++ai)
#pragma unroll
            for (int m = 0; m < 4; ++m) {
                float h[8];
#pragma unroll
                for (int n = 0; n < 2; ++n)
#pragma unroll
                    for (int j = 0; j < 4; ++j) h[4 * n + j] = siluf_(acc[ai][0][m][n][j]) * acc[ai][1][m][n][j];
                u32x4 w; w.x = pk2(h[0], h[1]); w.y = pk2(h[2], h[3]); w.z = pk2(h[4], h[5]); w.w = pk2(h[6], h[7]);
                __builtin_nontemporal_store(w, (u32x4*)(H + (size_t)(row0 + ai * 128 + m * 16) * DFF + col0));
            }
    }
};
struct EpiMerge {
    static constexpr bool PERM = true;
    bf16* MG; const bf16* GT; bf16* SCR; const float* pool_scale;
    __device__ __forceinline__ void operator()(const f32x4 (&acc)[2][2][4][2], const Unit& u, int wr, int wc, int fr, int fq) const {
        const int row0 = u.pm * 256 + wr * 64 + fr, col0 = u.pn * 256 + wc * 32 + 8 * fq, pass = u.aux;
        const int tid = (wr * 4 + wc) * 64 + fq * 16 + fr;
        const bf16* gt = GT + ((size_t)(u.pm * 24 + pass * 8 + u.pn) * 16 * 512 + tid) * 8;
        bf16* scr = SCR + ((size_t)blockIdx.x * 16 * 512 + tid) * 8;
#pragma unroll
        for (int bj = 0; bj < 2; ++bj) {
            const int col = col0 + bj * 128;
            u32x4 gw[8], pw[8];
#pragma unroll
            for (int q = 0; q < 8; ++q) gw[q] = *(const u32x4*)(gt + (q * 2 + bj) * 4096);
            if (pass != 0) {
#pragma unroll
                for (int q = 0; q < 8; ++q) pw[q] = *(const u32x4*)(scr + (q * 2 + bj) * 4096);
            }
            f32x4 s0 = (f32x4){1.f, 1.f, 1.f, 1.f}, s1 = s0;
            if (pass == 1) { s0 = *(const f32x4*)(pool_scale + col); s1 = *(const f32x4*)(pool_scale + col + 4); }
#pragma unroll
            for (int q = 0; q < 8; ++q) {
                const int ai = q >> 2, m = q & 3;
                f32x4 v0 = acc[ai][bj][m][0] * s0, v1 = acc[ai][bj][m][1] * s1;
                v0[0] *= bflo(gw[q].x); v0[1] *= bfhi(gw[q].x); v0[2] *= bflo(gw[q].y); v0[3] *= bfhi(gw[q].y);
                v1[0] *= bflo(gw[q].z); v1[1] *= bfhi(gw[q].z); v1[2] *= bflo(gw[q].w); v1[3] *= bfhi(gw[q].w);
                if (pass != 0) {
                    v0[0] += bflo(pw[q].x); v0[1] += bfhi(pw[q].x); v0[2] += bflo(pw[q].y); v0[3] += bfhi(pw[q].y);
                    v1[0] += bflo(pw[q].z); v1[1] += bfhi(pw[q].z); v1[2] += bflo(pw[q].w); v1[3] += bfhi(pw[q].w); }
                u32x4 w; w.x = pk2(v0[0], v0[1]); w.y = pk2(v0[2], v0[3]); w.z = pk2(v1[0], v1[1]); w.w = pk2(v1[2], v1[3]);
                if (pass == 2) __builtin_nontemporal_store(w, (u32x4*)(MG + (size_t)(row0 + ai * 128 + m * 16) * D + col));
                else *(u32x4*)(scr + (q * 2 + bj) * 4096) = w;
            }
        }
    }
};
constexpr float RS128 = 0.08838834764831845f;
template <bool ISX> struct EpiChDft {
    static constexpr bool PERM = true;
    bf16* YT2; bf16* YC;
    __device__ __forceinline__ void operator()(const f32x4 (&acc)[2][2][4][2], const Unit& u, int wr, int wc, int fr, int fq) const {
        const int T = u.pm, g = u.pn; constexpr bool isx = ISX;
        bf16* base = isx ? YT2 + (size_t)T * 512 : YC; constexpr int sC = isx ? 32768 : 512, sR = isx ? 128 : 256, sB = isx ? 256 : 128;
        bf16* p0 = base + (size_t)(g * 128 + wr * 64 + fr) * sC + wc * 32 + 8 * fq;
#pragma unroll
        for (int ai = 0; ai < 2; ++ai)
#pragma unroll
            for (int m = 0; m < 4; ++m)
#pragma unroll
                for (int bj = 0; bj < 2; ++bj) {
                    const f32x4 v0 = acc[ai][bj][m][0] * RS128, v1 = acc[ai][bj][m][1] * RS128;
                    u32x4 w; w.x = pk2(v0[0], v0[1]); w.y = pk2(v0[2], v0[3]); w.z = pk2(v1[0], v1[1]); w.w = pk2(v1[2], v1[3]);
                    *(u32x4*)(p0 + (size_t)(m * 16) * sC + ai * sR + bj * sB) = w;
                }
    }
};
struct EpiFftA {
    static constexpr bool PERM = true;
    bf16* ZT;
    __device__ __forceinline__ void operator()(const f32x4 (&acc)[2][2][4][2], const Unit& u, int wr, int wc, int fr, int fq) const {
        const int T = u.pm;
#pragma unroll
        for (int ai = 0; ai < 2; ++ai)
#pragma unroll
            for (int m = 0; m < 4; ++m) {
                const int k1 = wr * 64 + m * 16 + fr;
#pragma unroll
                for (int bj = 0; bj < 2; ++bj) {
                    const int cc = 2 * T + bj, t_lo = wc * 32 + 8 * fq;
                    const f32x4 v0 = acc[ai][bj][m][0] * RS128, v1 = acc[ai][bj][m][1] * RS128;
                    u32x4 w; w.x = pk2(v0[0], v0[1]); w.y = pk2(v0[2], v0[3]); w.z = pk2(v1[0], v1[1]); w.w = pk2(v1[2], v1[3]);
                    *(u32x4*)(ZT + (((size_t)k1 * 512 + cc) * 2 + ai) * 128 + t_lo) = w;
                }
            }
    }
};
struct EpiFftC {
    static constexpr bool PERM = true;
    bf16* FO;
    __device__ __forceinline__ void operator()(const f32x4 (&acc)[2][2][4][2], const Unit& u, int wr, int wc, int fr, int fq) const {
        const bool isc = u.aux != 0; const float sc = isc ? 0.0625f : RS128;
        const int rbase = isc ? L : u.pm, rstr = isc ? 1 : 128;
        bf16* p0 = FO + (size_t)(rbase + (wr * 64 + fr) * rstr) * DFO + u.pn * 256 + wc * 32 + 8 * fq;
#pragma unroll
        for (int ai = 0; ai < 2; ++ai) {
            if (ai == 1 && !isc) continue;
#pragma unroll
            for (int m = 0; m < 4; ++m)
#pragma unroll
                for (int bj = 0; bj < 2; ++bj) {
                    const f32x4 v0 = acc[ai][bj][m][0] * sc, v1 = acc[ai][bj][m][1] * sc;
                    u32x4 w; w.x = pk2(v0[0], v0[1]); w.y = pk2(v0[2], v0[3]); w.z = pk2(v1[0], v1[1]); w.w = pk2(v1[2], v1[3]);
                    *(u32x4*)(p0 + (size_t)((ai * 128 + m * 16) * rstr) * DFO + bj * 128) = w;
                }
        }
    }
};

__device__ __forceinline__ void transpose_item(const float* W, int srcN, bf16* WT, int dpitch, int k0, int n0, int drow0, LAS float* scr, int lane) {
    f32x4 v[16];
#pragma unroll
    for (int i = 0; i < 16; ++i) v[i] = *(const f32x4*)(W + (size_t)(k0 + 4 * i + (lane >> 4)) * srcN + n0 + (lane & 15) * 4);
#pragma unroll
    for (int i = 0; i < 16; ++i) { LAS float* s = scr + (4 * i + (lane >> 4)) * 65 + (lane & 15) * 4; s[0] = v[i].x; s[1] = v[i].y; s[2] = v[i].z; s[3] = v[i].w; }
    asm volatile("s_waitcnt lgkmcnt(0)" ::: "memory");
    const int c = lane & 7;
#pragma unroll
    for (int j = 0; j < 8; ++j) { const int n = (lane >> 3) + 8 * j; const LAS float* s = scr + (8 * c) * 65 + n;
        u32x4 o; o.x = pk2(s[0 * 65], s[1 * 65]); o.y = pk2(s[2 * 65], s[3 * 65]); o.z = pk2(s[4 * 65], s[5 * 65]); o.w = pk2(s[6 * 65], s[7 * 65]);
        *(u32x4*)(WT + (size_t)(drow0 + n) * dpitch + k0 + 8 * c) = o; }
    asm volatile("s_waitcnt lgkmcnt(0)" ::: "memory");
}
constexpr int CI_IN = 32 * 144, CI_LO = 16 * 32, CI_POOL = 4 * 16, CI_F = 8 * 32, CI_OUT = 32 * 32, CI_FFI = 32 * 176, CI_FFO = 88 * 32, CI_G = 32 * 4;
constexpr int CI_LAYER = CI_IN + CI_LO + CI_POOL + CI_F + CI_OUT + CI_FFI + CI_FFO + CI_G;
__device__ __forceinline__ void conv_item(KP a, int l, int r, LAS float* scr, int lane) {
    unsigned char* wl = a->ws + OFF_W + (size_t)l * W_LAYER;
    if (r < CI_IN) { const int kb = r / 144, nb = r % 144; transpose_item(a->w_in + (size_t)l * D * DIN, DIN, (bf16*)(wl + W_IN), D, 64 * kb, 64 * nb, 64 * nb, scr, lane); return; } r -= CI_IN;
    if (r < CI_LO) { const int kb = r / 32, nb = r % 32; transpose_item(a->w_lru_out + (size_t)l * DLRU * D, D, (bf16*)(wl + W_LO), DLRU, 64 * kb, 64 * nb, 64 * nb, scr, lane); return; } r -= CI_LO;
    if (r < CI_POOL) { const int g = r / 16, rr = r % 16, kb = rr / 8, nb = rr % 8; transpose_item(a->w_pool + (size_t)(l * 4 + g) * 128 * 512, 512, (bf16*)(wl + W_POOL), 128, 64 * kb, 64 * nb, g * 512 + 64 * nb, scr, lane); return; } r -= CI_POOL;
    if (r < CI_F) { const int kb = r / 32, nb = r % 32; transpose_item(a->w_fourier + (size_t)l * DFO * D, D, (bf16*)(wl + W_F), DFO, 64 * kb, 64 * nb, 64 * nb, scr, lane); return; } r -= CI_F;
    if (r < CI_OUT) { const int kb = r / 32, nb = r % 32; transpose_item(a->w_out + (size_t)l * D * D, D, (bf16*)(wl + W_OUT), D, 64 * kb, 64 * nb, 64 * nb, scr, lane); return; } r -= CI_OUT;
    if (r < CI_FFI) { const int kb = r / 176, nb = r % 176, n0 = 64 * nb, half = n0 >= DFF ? 1 : 0, hu = n0 - half * DFF;
        transpose_item(a->w_ffn_in + (size_t)l * D * 2 * DFF, 2 * DFF, (bf16*)(wl + W_FFI), D, 64 * kb, n0, (hu >> 7) * 256 + half * 128 + (hu & 127), scr, lane); return; } r -= CI_FFI;
    if (r < CI_FFO) { const int kb = r / 32, nb = r % 32; transpose_item(a->w_ffn_out + (size_t)l * DFF * D, D, (bf16*)(wl + W_FFO), DFF, 64 * kb, 64 * nb, 64 * nb, scr, lane); return; } r -= CI_FFO;
    { const int idx = r / 4, rr = r % 4, kb = rr / 2, nb = rr % 2, d = idx >> 4, mat = (idx >> 3) & 1, h = idx & 7;
      const float* src = (mat ? a->lru_wx : a->lru_wa) + (size_t)((l * 2 + d) * 8 + h) * 16384;
      transpose_item(src, 128, (bf16*)(wl + W_G) + (size_t)idx * 16384, 128, 64 * kb, 64 * nb, 64 * nb, scr, lane); }
}
__device__ __forceinline__ void table_elem(KP a, int idx) {
    float s, c;
    if (idx < 256 * 128) { const int n = idx / 128, j = idx % 128, m = n & 127, ph = (m * j) & 127; sincospif((float)ph * (1.0f / 64.0f), &s, &c);
        ((bf16*)(a->ws + OFF_DCH))[idx] = (bf16)f2bf(n < 128 ? c : -s); return; } idx -= 256 * 128;
    if (idx < 256 * 256) { const int n = idx / 256, k = idx % 256, k1 = n & 127, rip = n >> 7, t = k & 127, ri = k >> 7, ph = (k1 * t) & 127; sincospif((float)ph * (1.0f / 64.0f), &s, &c);
        const float v = rip == 0 ? (ri == 0 ? c : s) : (ri == 0 ? -s : c); ((bf16*)(a->ws + OFF_DA))[idx] = (bf16)f2bf(v); return; } idx -= 256 * 256;
    if (idx < 256 * 512) { const int k = idx / 512, kk = idx % 512, t = kk & 255, ri = kk >> 8, ph = (k * t) & 255; sincospif((float)ph * (1.0f / 128.0f), &s, &c);
        ((bf16*)(a->ws + OFF_DC))[idx] = (bf16)f2bf(ri == 0 ? c : s); return; } idx -= 256 * 512;
    { const int rr = idx / 256, k = idx % 256; float v = 0.f;
      if (rr < 16384) { const int k1 = rr >> 7, k2 = rr & 127, kk = k1 + 128 * k2, t_lo = k & 127, ri = k >> 7, ph = (kk * t_lo) & 16383; sincospif((float)ph * (1.0f / 8192.0f), &s, &c); v = ri == 0 ? c : s; }
      ((bf16*)(a->ws + OFF_E))[idx] = (bf16)f2bf(v); }
}
constexpr int N_TABLE = 256 * 128 + 256 * 256 + 256 * 512 + (16384 + 128) * 256;

__device__ __forceinline__ void conv_range(KP a, int l, int r_lo, int r_hi, int b0, int G, LAS unsigned char* lds) {
    if ((int)blockIdx.x < b0) return;
    int tid_ = threadIdx.x; asm volatile("" : "+v"(tid_)); const int tid = tid_, lane = tid & 63, wave = tid >> 6;
    LAS float* scr = (LAS float*)(lds + wave * 16896);
    for (int it = r_lo + ((int)blockIdx.x - b0) * NWAVES + wave; it < r_hi; it += (G - b0) * NWAVES) conv_item(a, l, it, scr, lane);
}
constexpr int CR_FFI0 = CI_IN + CI_LO + CI_POOL + CI_F + CI_OUT, CR_G0 = CR_FFI0 + CI_FFI + CI_FFO;
__device__ __forceinline__ void phase_prologue(KP a, LAS unsigned char* lds, int G) {
    int tid_ = threadIdx.x; asm volatile("" : "+v"(tid_)); const int tid = tid_, lane = tid & 63, wave = tid >> 6;
    for (int it = blockIdx.x; it < 96; it += G) {
        const int l = it / 48, nb = it % 48;
        const float* Wl = a->w_ada + (size_t)l * D * 6 * D + nb * 256 + lane * 4;
        f32x4 a0 = (f32x4){0.f, 0.f, 0.f, 0.f}, a1 = a0;
        for (int k0 = wave * 256; k0 < wave * 256 + 256; k0 += 16) {
            f32x4 w[16];
#pragma unroll
            for (int j = 0; j < 16; ++j) w[j] = *(const f32x4*)(Wl + (size_t)(k0 + j) * 6 * D);
#pragma unroll
            for (int j = 0; j < 16; ++j) { const float sx = siluf_(a->c[k0 + j]), sc = siluf_(a->c_ctx[k0 + j]); a0 += w[j] * sx; a1 += w[j] * sc; }
        }
        LAS f32x4* red = (LAS f32x4*)lds;
        red[(wave * 2 + 0) * 64 + lane] = a0; red[(wave * 2 + 1) * 64 + lane] = a1;
        __syncthreads();
        if (tid < 128) { const int s = tid >> 6, ln = tid & 63; f32x4 r = *(const f32x4*)(a->b_ada + (size_t)l * 6 * D + nb * 256 + ln * 4);
            for (int w = 0; w < 8; ++w) r += red[(w * 2 + s) * 64 + ln];
            *(f32x4*)((float*)(a->ws + OFF_MODS) + (size_t)(l * 2 + s) * 6 * D + nb * 256 + ln * 4) = r; }
        __syncthreads();
    }
    for (int idx = blockIdx.x * NTHREADS + tid; idx < LC * D / 4; idx += G * NTHREADS) ((f32x4*)(a->ws + OFF_XC))[idx] = ((const f32x4*)a->ctx)[idx];
    for (int idx = blockIdx.x * NTHREADS + tid; idx < N_TABLE; idx += G * NTHREADS) table_elem(a, idx);
    __syncthreads();
    conv_range(a, 0, 0, CR_FFI0, 0, G, lds);
    conv_range(a, 0, CR_G0, CI_LAYER, 0, G, lds);
}

template <int RB>
__device__ __forceinline__ void phase_norm(const float* resx, float* resc, const float* gvec, const float* modx, const float* modc, int sh_idx, bf16* U, int row_lo, int row_hi, int wv0, int nwv, const float* part, int nsum) {
    int tid_ = threadIdx.x; asm volatile("" : "+v"(tid_)); const int tid = tid_, lane = tid & 63, wave = tid >> 6;
    for (int rowb = row_lo + wv0 + wave; rowb < row_hi; rowb += nwv * RB) {
        f32x4 v[RB][8]; float s[RB];
#pragma unroll
        for (int b = 0; b < RB; ++b) { const int row = rowb + b * nwv; s[b] = 0.f;
            if (row < row_hi) { const float* xr = (row >= L) ? resc + (size_t)(row - L) * D : resx + (size_t)row * D;
#pragma unroll
                for (int j = 0; j < 8; ++j) v[b][j] = *(const f32x4*)(xr + 4 * lane + 256 * j);
                if (row >= L && nsum > 0) {
                    for (int s2 = 0; s2 < nsum; ++s2) {
#pragma unroll
                        for (int j = 0; j < 8; ++j) v[b][j] += *(const f32x4*)(part + ((size_t)s2 * LC + (row - L)) * D + 4 * lane + 256 * j); }
#pragma unroll
                    for (int j = 0; j < 8; ++j) *(f32x4*)(resc + (size_t)(row - L) * D + 4 * lane + 256 * j) = v[b][j]; } } }
#pragma unroll
        for (int b = 0; b < RB; ++b) { const int row = rowb + b * nwv;
            if (row < row_hi) {
#pragma unroll
                for (int j = 0; j < 8; ++j) s[b] += (v[b][j].x * v[b][j].x + v[b][j].y * v[b][j].y) + (v[b][j].z * v[b][j].z + v[b][j].w * v[b][j].w);
                const float rstd = 1.0f / sqrtf(wave_sum(s[b], lane) * (1.0f / D) + NORM_EPS);
                const float* mod = (row >= L) ? modc : modx;
#pragma unroll
                for (int j = 0; j < 8; ++j) { const int col = 4 * lane + 256 * j;
                    const f32x4 g = *(const f32x4*)(gvec + col), sh = *(const f32x4*)(mod + sh_idx * D + col), sc = *(const f32x4*)(mod + (sh_idx + 1) * D + col);
                    const f32x4 y = v[b][j] * rstd * g * (sc + 1.0f) + sh;
                    u32x2 w; w.x = pk2(y.x, y.y); w.y = pk2(y.z, y.w); *(u32x2*)(U + (size_t)row * D + col) = w; } } }
    }
}
__device__ __forceinline__ void phase_final(float* out, const float* gvec, int G) {
    int tid_ = threadIdx.x; asm volatile("" : "+v"(tid_)); const int tid = tid_, lane = tid & 63, wave = tid >> 6;
    const int gw = blockIdx.x * NWAVES + wave, NGW = G * NWAVES;
    for (int row = gw; row < L; row += NGW) {
        float* xr = out + (size_t)row * D;
        f32x4 v[8]; float s = 0.f;
#pragma unroll
        for (int j = 0; j < 8; ++j) { v[j] = *(const f32x4*)(xr + 4 * lane + 256 * j); s += (v[j].x * v[j].x + v[j].y * v[j].y) + (v[j].z * v[j].z + v[j].w * v[j].w); }
        const float rstd = 1.0f / sqrtf(wave_sum(s, lane) * (1.0f / D) + NORM_EPS);
#pragma unroll
        for (int j = 0; j < 8; ++j) { const int col = 4 * lane + 256 * j; const f32x4 g = *(const f32x4*)(gvec + col); *(f32x4*)(xr + col) = v[j] * rstd * g; }
    }
}

__device__ __forceinline__ void phase_pool(const bf16* P, bf16* PL, int G, int nrows) {
    const int total = nrows * 64;
    int tid_ = threadIdx.x; asm volatile("" : "+v"(tid_));
    for (int it = blockIdx.x * NTHREADS + tid_; it < total; it += G * NTHREADS) {
        const int row = it >> 6, c8 = it & 63, g = c8 >> 4, W = 2 << g;
        int base, w, width;
        if (row < L) { base = row & ~63; w = row & 63; width = 64; } else { base = L; w = row - L; width = 256; }
        int lo = w - W / 2, hi = lo + W; lo = lo < 0 ? 0 : lo; hi = hi > width ? width : hi;
        float sum[8] = {0.f, 0.f, 0.f, 0.f, 0.f, 0.f, 0.f, 0.f};
        u32x4 qq[16];
#pragma unroll
        for (int j = 0; j < 16; ++j) { const int p = lo + j; qq[j] = (p < hi) ? *(const u32x4*)(P + (size_t)(base + p) * PP + I_XB + 8 * c8) : (u32x4){0u, 0u, 0u, 0u}; }
#pragma unroll
        for (int j = 0; j < 16; ++j) { const u32x4 q = qq[j];
            sum[0] += bflo(q.x); sum[1] += bfhi(q.x); sum[2] += bflo(q.y); sum[3] += bfhi(q.y); sum[4] += bflo(q.z); sum[5] += bfhi(q.z); sum[6] += bflo(q.w); sum[7] += bfhi(q.w); }
        const u32x4 q = *(const u32x4*)(P + (size_t)row * PP + I_XB + 8 * c8);
        const float inv = 1.0f / (float)(hi - lo);
        u32x4 o; o.x = pk2(sum[0] * inv - bflo(q.x), sum[1] * inv - bfhi(q.x)); o.y = pk2(sum[2] * inv - bflo(q.y), sum[3] * inv - bfhi(q.y));
        o.z = pk2(sum[4] * inv - bflo(q.z), sum[5] * inv - bfhi(q.z)); o.w = pk2(sum[6] * inv - bflo(q.w), sum[7] * inv - bfhi(q.w));
        *(u32x4*)(PL + (size_t)row * DP + 8 * c8) = o;
    }
}

constexpr int XCV_P = 136;

constexpr int L3_XCV = 0, L3_GY = 2 * 17408, L3_CW = L3_GY + 2 * 16384;
static_assert(L3_CW + 2560 <= LDS_BYTES - 64, "lru3 lds");
template <bool PASS3>
__device__ __forceinline__ void phase_lru3(KP a, int l, LAS unsigned char* lds, int G, int nch) {
    int tid_ = threadIdx.x; asm volatile("" : "+v"(tid_)); const int tid = tid_;
    const int h = blockIdx.x & 7, step = G >> 3;
    const bf16* P = (const bf16*)(a->ws + OFF_P);
    const bf16* WG = (const bf16*)(a->ws + OFF_W + (size_t)l * W_LAYER + W_G);
    f32x2* AGG = (f32x2*)(a->ws + OFF_AGG);
    const float* CARRY = (const float*)(a->ws + OFF_CARRY);
    bf16* ALRU = (bf16*)(a->ws + OFF_ALRU);
    LAS float* CW = (LAS float*)(lds + L3_CW);
    for (int i = tid; i < 640; i += NTHREADS) CW[i] = (i < 512) ? a->conv_w[(size_t)(l * 4 + (i >> 7)) * DLRU + h * 128 + (i & 127)] : a->conv_b[(size_t)l * DLRU + h * 128 + (i - 512)];
    __syncthreads();
    bf16x8 wf[2][2][4];
    float ba_[2], bx_[2], sp_[2];
    {
        const int lane = tid & 63, n = 16 * (tid >> 6) + (lane & 15), quad = lane >> 4, cfull = h * 128 + n;
#pragma unroll
        for (int d = 0; d < 2; ++d) {
#pragma unroll
            for (int mtx = 0; mtx < 2; ++mtx)
#pragma unroll
                for (int ks = 0; ks < 4; ++ks) wf[d][mtx][ks] = *(const bf16x8*)(WG + (size_t)((d * 2 + mtx) * 8 + h) * 16384 + n * 128 + quad * 8 + ks * 32);
            ba_[d] = a->lru_ba[(size_t)(l * 2 + d) * DLRU + cfull]; bx_[d] = a->lru_bx[(size_t)(l * 2 + d) * DLRU + cfull];
            const float lam = a->lru_lambda[(size_t)(l * 2 + d) * DLRU + cfull]; sp_[d] = softplus_neg(lam);
        }
    }
    u32x4 q[2][4], gq[2];
    auto fetch = [&](int ch) {
        int tl = tid; asm volatile("" : "+v"(tl)); const int tr = tl >> 4, cf = h * 128 + (tl & 15) * 8;
        int rowbase, p0, seglen;
        if (ch < 256) { rowbase = 0; p0 = 64 * ch; seglen = L; } else { rowbase = L; p0 = 64 * (ch - 256); seglen = LC; }
        if (ch >= 256 && l == 1) {
            const float* XA1 = (const float*)(a->ws + OFF_PART);
#pragma unroll
            for (int rr = 0; rr < 2; ++rr)
#pragma unroll
                for (int k = 0; k < 4; ++k) { const int p = p0 + tr + 32 * rr + k - 2; u32x4 w = (u32x4){0u, 0u, 0u, 0u};
                    if (p >= 0 && p < seglen) { f32x4 v0 = (f32x4){0.f, 0.f, 0.f, 0.f}, v1 = v0;
                        for (int s2 = 0; s2 < 8; ++s2) { v0 += *(const f32x4*)(XA1 + ((size_t)s2 * LC + p) * DLRU + cf); v1 += *(const f32x4*)(XA1 + ((size_t)s2 * LC + p) * DLRU + cf + 4); }
                        w.x = pk2(v0.x, v0.y); w.y = pk2(v0.z, v0.w); w.z = pk2(v1.x, v1.y); w.w = pk2(v1.z, v1.w); }
                    q[rr][k] = w; }
        } else
#pragma unroll
        for (int rr = 0; rr < 2; ++rr)
#pragma unroll
            for (int k = 0; k < 4; ++k) { const int p = p0 + tr + 32 * rr + k - 2;
                q[rr][k] = (p >= 0 && p < seglen) ? *(const u32x4*)(P + (size_t)(rowbase + p) * PP + cf) : (u32x4){0u, 0u, 0u, 0u}; }
        if (PASS3) {
#pragma unroll
            for (int rr = 0; rr < 2; ++rr) gq[rr] = *(const u32x4*)(P + (size_t)(rowbase + p0 + tr + 32 * rr) * PP + I_YA + cf);
        }
    };
    int ch = blockIdx.x >> 3, it = 0;
    if (ch < nch) fetch(ch);
    for (; ch < nch; ch += step, ++it) {
        const int rowbase = ch < 256 ? 0 : L, p0 = ch < 256 ? 64 * ch : 64 * (ch - 256);
        LAS bf16* XCV = (LAS bf16*)(lds + L3_XCV + (it & 1) * 17408);
        LAS bf16* GY = (LAS bf16*)(lds + L3_GY + (it & 1) * 16384);
        int tl = tid; asm volatile("" : "+v"(tl));
        const int c8 = tl & 15, tr = tl >> 4, cf = h * 128 + c8 * 8, lane = tl & 63, n = 16 * (tl >> 6) + (lane & 15), quad = lane >> 4;
#pragma unroll
        for (int rr = 0; rr < 2; ++rr) {
            float o[8];
            { const f32x4 b0 = *(const LAS f32x4*)(CW + 512 + c8 * 8), b1 = *(const LAS f32x4*)(CW + 512 + c8 * 8 + 4);
              o[0] = b0.x; o[1] = b0.y; o[2] = b0.z; o[3] = b0.w; o[4] = b1.x; o[5] = b1.y; o[6] = b1.z; o[7] = b1.w; }
#pragma unroll
            for (int k = 0; k < 4; ++k) { const u32x4 v = q[rr][k];
                const f32x4 w0 = *(const LAS f32x4*)(CW + k * 128 + c8 * 8), w1 = *(const LAS f32x4*)(CW + k * 128 + c8 * 8 + 4);
                o[0] += w0.x * bflo(v.x); o[1] += w0.y * bfhi(v.x); o[2] += w0.z * bflo(v.y); o[3] += w0.w * bfhi(v.y);
                o[4] += w1.x * bflo(v.z); o[5] += w1.y * bfhi(v.z); o[6] += w1.z * bflo(v.w); o[7] += w1.w * bfhi(v.w); }
            u32x4 w; w.x = pk2(o[0], o[1]); w.y = pk2(o[2], o[3]); w.z = pk2(o[4], o[5]); w.w = pk2(o[6], o[7]);
            *(LAS u32x4*)(XCV + (tr + 32 * rr) * XCV_P + c8 * 8) = w;
            if (PASS3) *(LAS u32x4*)(GY + (tr + 32 * rr) * 128 + c8 * 8) = gq[rr];
        }
        float hin[2] = {0.f, 0.f};
        if (PASS3) { hin[0] = CARRY[((size_t)0 * NCH + ch) * DLRU + h * 128 + n]; hin[1] = CARRY[((size_t)1 * NCH + ch) * DLRU + h * 128 + n]; }
        if (ch + step < nch) fetch(ch + step);
        __syncthreads();
        float hf[4][4];
        const int p16 = (lane ^ 16) << 2, p32 = (lane ^ 32) << 2;
#pragma unroll
        for (int d = 0; d < 2; ++d) {
            f32x4 acc[2][4];
#pragma unroll
            for (int mtx = 0; mtx < 2; ++mtx)
#pragma unroll
                for (int rb = 0; rb < 4; ++rb) acc[mtx][rb] = (f32x4){0.f, 0.f, 0.f, 0.f};
#pragma unroll
            for (int ks = 0; ks < 4; ++ks)
#pragma unroll
                for (int rb = 0; rb < 4; ++rb) { const bf16x8 av = *(const LAS bf16x8*)(XCV + (16 * rb + (lane & 15)) * XCV_P + ks * 32 + quad * 8);
                    acc[0][rb] = __builtin_amdgcn_mfma_f32_16x16x32_bf16(av, wf[d][0][ks], acc[0][rb], 0, 0, 0);
                    acc[1][rb] = __builtin_amdgcn_mfma_f32_16x16x32_bf16(av, wf[d][1][ks], acc[1][rb], 0, 0, 0);
                    if (rb == 3) __builtin_amdgcn_sched_barrier(0); }
            float Hc = hin[d], TA = 1.f, TB = 0.f;
            const bool first1 = ((quad & 1) == d), firstp = (((quad >> 1) & 1) == d);
#pragma unroll
            for (int rbi = 0; rbi < 4; ++rbi) {
                const int rb = d ? 3 - rbi : rbi;
                __builtin_amdgcn_sched_barrier(0);
                float ea[4], eb[4];
#pragma unroll
                for (int j = 0; j < 4; ++j) { const int t = 16 * rb + 4 * quad + j;
                    const float r = fsigmoid(acc[0][rb][j] + ba_[d]), ig = fsigmoid(acc[1][rb][j] + bx_[d]), xv = bf2f(XCV[t * XCV_P + n]);
                    const float la = -8.0f * r * sp_[d], av = __builtin_amdgcn_exp2f(la * 1.4426950408889634f);
                    const float y = 2.0f * la;
                    const float ser = -y * (1.0f + y * (0.5f + y * (0.16666667f + y * (0.041666668f + y * 0.0083333338f))));
                    const float om = (y > -0.25f) ? ser : (1.0f - av * av);
                    ea[j] = av; eb[j] = __builtin_amdgcn_sqrtf(om) * (ig * xv); }
                float pA[4], pB[4];
                if (d == 0) { pA[0] = ea[0]; pB[0] = eb[0];
#pragma unroll
                    for (int j = 1; j < 4; ++j) { pA[j] = pA[j - 1] * ea[j]; pB[j] = ea[j] * pB[j - 1] + eb[j]; } }
                else { pA[3] = ea[3]; pB[3] = eb[3];
#pragma unroll
                    for (int j = 2; j >= 0; --j) { pA[j] = pA[j + 1] * ea[j]; pB[j] = ea[j] * pB[j + 1] + eb[j]; } }
                const float LA_ = d ? pA[0] : pA[3], LB_ = d ? pB[0] : pB[3];
                const float xA = __builtin_bit_cast(float, __builtin_amdgcn_ds_bpermute(p16, __builtin_bit_cast(int, LA_)));
                const float xB = __builtin_bit_cast(float, __builtin_amdgcn_ds_bpermute(p16, __builtin_bit_cast(int, LB_)));
                const float PTA = LA_ * xA, PTB = first1 ? (xA * LB_ + xB) : (LA_ * xB + LB_);
                float EA = first1 ? 1.f : xA, EB = first1 ? 0.f : xB;
                const float oA = __builtin_bit_cast(float, __builtin_amdgcn_ds_bpermute(p32, __builtin_bit_cast(int, PTA)));
                const float oB = __builtin_bit_cast(float, __builtin_amdgcn_ds_bpermute(p32, __builtin_bit_cast(int, PTB)));
                const float QA = PTA * oA, QB = firstp ? (oA * PTB + oB) : (PTA * oB + PTB);
                if (!firstp) { EB = EA * oB + EB; EA = oA * EA; }
                if (PASS3) {
                    const float hs = EA * Hc + EB;
#pragma unroll
                    for (int j = 0; j < 4; ++j) { const float hv = pA[j] * hs + pB[j];
                        if (d == 0) hf[rb][j] = hv;
                        else { const int t = 16 * rb + 4 * quad + j; GY[t * 128 + n] = (bf16)f2bf((hf[rb][j] + hv) * bf2f(GY[t * 128 + n])); } }
                    Hc = QA * Hc + QB;
                } else { TB = QA * TB + QB; TA = TA * QA; }
            }
            if (!PASS3) { if (quad == 0) AGG[((size_t)d * NCH + ch) * DLRU + h * 128 + n] = (f32x2){TA, TB}; }
        }
        if (PASS3) {
            __syncthreads();
#pragma unroll
            for (int rr = 0; rr < 2; ++rr) *(u32x4*)(ALRU + (size_t)(rowbase + p0 + tr + 32 * rr) * DLRU + cf) = *(const LAS u32x4*)(GY + (tr + 32 * rr) * 128 + c8 * 8);
        }
    }
}

__device__ __forceinline__ void phase_carry(KP a, int G) {
    int tid_ = threadIdx.x; asm volatile("" : "+v"(tid_)); const int tid = tid_;
    if (blockIdx.x >= 32 || tid >= 64) return;
    const int seq = blockIdx.x * 64 + tid, d = seq >> 10, cf = seq & 1023;
    const f32x2* AGG = (const f32x2*)(a->ws + OFF_AGG) + (size_t)d * NCH * DLRU + cf;
    float* CARRY = (float*)(a->ws + OFF_CARRY) + (size_t)d * NCH * DLRU + cf;
    float hh = 0.f;
    for (int s0 = 0; s0 < NCH; s0 += 20) {
        f32x2 ab[20]; int id[20];
#pragma unroll
        for (int j = 0; j < 20; ++j) { const int s = s0 + j; id[j] = (s < 4) ? 256 + (d ? 3 - s : s) : (d ? 255 - (s - 4) : s - 4); ab[j] = AGG[(size_t)id[j] * DLRU]; }
#pragma unroll
        for (int j = 0; j < 20; ++j) { CARRY[(size_t)id[j] * DLRU] = hh; hh = ab[j].x * hh + ab[j].y; }
    }
}
#ifndef PH_MASK
#define PH_MASK 0xFFFFF
#endif
#define EN(k) ((PH_MASK >> (k)) & 1)
#ifndef DUP_PH
#define DUP_PH -1
#endif
#ifndef DUP_SYNC
#define DUP_SYNC 0
#endif
#ifndef WGM_WIN
#define WGM_WIN 4
#endif
#ifndef WGM_MRG
#define WGM_MRG 4
#endif
#ifndef WGM_N8
#define WGM_N8 4
#endif
#ifndef WGM_FFI
#define WGM_FFI 4
#endif
constexpr int N_PHASES = 22;
__global__ void __launch_bounds__(NTHREADS, 2) mega(Args a_unused) {
    KP a = (KP)__builtin_amdgcn_kernarg_segment_ptr();
    extern __shared__ __attribute__((aligned(16))) unsigned char lds_raw[];
    LAS unsigned char* lds = (LAS unsigned char*)lds_raw;
    const int G = gridDim.x, bid = blockIdx.x;
    const int ph_lo = a->ph_lo, ph_hi = a->ph_hi;
    volatile LAS unsigned* MISC = (volatile LAS unsigned*)(lds + LDS_BYTES - 64);
    if (threadIdx.x < 2) MISC[threadIdx.x] = 0u;
    __syncthreads();
    const XcdBarrier bar = xcd_barrier_post((unsigned*)(a->ws + OFF_BAR), MISC);
    if (ph_lo < 0) cg::this_grid().sync();
    for (int vp = ph_lo; vp < ph_hi + (DUP_PH >= 0 ? 1 : 0); ++vp) {
      const int ph = (DUP_PH >= 0 && vp > DUP_PH) ? vp - 1 : vp;
      {
        asm volatile("" : "+s"(a));
        unsigned char* ws = a->ws;
        const float* MODS = (const float*)(ws + OFF_MODS);
        float* XC = (float*)(ws + OFF_XC);
        bf16* UB = (bf16*)(ws + OFF_UB); bf16* P = (bf16*)(ws + OFF_P); bf16* HB = (bf16*)(ws + OFF_P);
        if (ph == 0) { if (EN(10)) phase_prologue(a, lds, G); }
        else if (ph == N_PHASES - 1) { if (EN(11)) phase_final(a->out, a->norm_f_g, G); }
        else {
            const int l = (ph - 1) / 10, sp = (ph - 1) % 10;
            const unsigned char* wl = ws + OFF_W + (size_t)l * W_LAYER;
            const float* modx = MODS + (size_t)(l * 2 + 0) * 6 * D; const float* modc = MODS + (size_t)(l * 2 + 1) * 6 * D;
            const bool lastl = (l == 1);
            if (sp == 0 && EN(0)) { const bool first = (l == 0);
                phase_norm<2>(first ? a->x : a->out, XC, a->norm1_g + (size_t)l * D, modx, modc, 0, UB, 0, MT, bid * NWAVES, G * NWAVES, (const float*)(ws + OFF_PART), lastl ? 11 : 0); }
            else if (sp == 1 && EN(1)) { PlainSched S; S.T.init(64, DIN / 256, G, bid, WGM_WIN); S.A = (const char*)UB; S.B = (const char*)(wl + W_IN); S.pitchA = D * 2; S.pitchB = D * 2; S.nt = D / 64;
                S.extra = lastl ? 4 * 8 : DIN / 256; S.xn = lastl ? 4 : DIN / 256; S.xnt = lastl ? 4 : D / 64;
                EpiWin E{P, (bf16*)(ws + OFF_GT), a->b_gate + (size_t)l * 3 * D, (float*)(ws + OFF_PART)}; pg8::gemm_phase(lds, S, E);
                if (!lastl) { __syncthreads(); conv_range(a, 0, CR_FFI0, CR_G0, DIN / 256, G, lds); } }
            else if (sp == 2 && EN(2)) {
                if (EN(12)) { ChDftSched S{G, bid, (const char*)(ws + OFF_DCH), (const char*)P, 0}; EpiChDft<true> E{(bf16*)(ws + OFF_YT2), (bf16*)(ws + OFF_YC)}; pg8::gemm_phase(lds, S, E); }
                if (EN(12) && !lastl) { ChDftSched S{G, bid, (const char*)(ws + OFF_DCH), (const char*)P, 1}; EpiChDft<false> E{(bf16*)(ws + OFF_YT2), (bf16*)(ws + OFF_YC)}; pg8::gemm_phase(lds, S, E); }
                __syncthreads();
                if (EN(13)) phase_pool(P, (bf16*)(ws + OFF_PL), G, lastl ? L : MT);
                if (EN(14)) phase_lru3<false>(a, l, lds, G, NCH);
            }
            else if (sp == 3 && EN(3)) {
                phase_carry(a, G);
                __syncthreads();
                if (EN(12)) { FftASched S{G, bid, (const char*)(ws + OFF_DA), (const char*)(ws + OFF_YT2)}; EpiFftA E{(bf16*)(ws + OFF_ZT)}; pg8::gemm_phase(lds, S, E); }
            }
            else if (sp == 4 && EN(4)) { FftCSched S{G, bid, (const char*)(ws + OFF_E), (const char*)(ws + OFF_ZT), (const char*)(ws + OFF_DC), (const char*)(ws + OFF_YC), lastl ? 256 : 258};
                EpiFftC E{(bf16*)(ws + OFF_FO)}; pg8::gemm_phase(lds, S, E);
                __syncthreads();
                if (EN(14)) phase_lru3<true>(a, l, lds, G, lastl ? 256 : NCH); }
            else if (sp == 5 && EN(5)) { MergeSched S; S.T.init(lastl ? 64 : 65, D / 256, G, bid, WGM_MRG); S.ALRU = (const char*)(ws + OFF_ALRU); S.PL = (const char*)(ws + OFF_PL); S.FO = (const char*)(ws + OFF_FO);
                S.WLO = (const char*)(wl + W_LO); S.WPOOL = (const char*)(wl + W_POOL); S.WF = (const char*)(wl + W_F);
                EpiMerge E{UB, (const bf16*)(ws + OFF_GT), (bf16*)(ws + OFF_YT2), a->pool_scale + (size_t)l * D}; pg8::gemm_phase(lds, S, E);
                if (!lastl) { __syncthreads(); conv_range(a, 1, 0, CI_IN, 8, G, lds); } }
            else if (sp == 6 && EN(6)) { PlainSched S; S.T.init(64, D / 256, G, bid, WGM_N8); S.A = (const char*)UB; S.B = (const char*)(wl + W_OUT); S.pitchA = D * 2; S.pitchB = D * 2; S.nt = D / 64;
                S.extra = lastl ? 0 : 8 * 8; S.xn = 8; S.xnt = 4;
                const bool first = (l == 0);
                EpiRes E{first ? a->x : a->out, a->out, XC, XC, modx + 2 * D, modc + 2 * D, (float*)(ws + OFF_PART)}; pg8::gemm_phase(lds, S, E); }
            else if (sp == 7 && EN(7)) phase_norm<2>(a->out, XC, a->norm2_g + (size_t)l * D, modx, modc, 3, UB, 0, lastl ? L : MT, bid * NWAVES, G * NWAVES, (const float*)(ws + OFF_PART), 8);
            else if (sp == 8 && EN(8)) { PlainSched S; S.T.init(64, 2 * DFF / 256, G, bid, WGM_FFI); S.A = (const char*)UB; S.B = (const char*)(wl + W_FFI); S.pitchA = D * 2; S.pitchB = D * 2; S.nt = D / 64;
                S.extra = lastl ? 0 : 2 * DFF / 256; S.xn = 2 * DFF / 256; S.xnt = D / 64;
                EpiFfi E{HB}; pg8::gemm_phase(lds, S, E);
                if (!lastl) { __syncthreads(); conv_range(a, 1, CI_IN, CI_LAYER, 2 * DFF / 256, G, lds); } }
            else if (EN(9)) { PlainSched S; S.T.init(64, D / 256, G, bid, WGM_N8); S.A = (const char*)HB; S.B = (const char*)(wl + W_FFO); S.pitchA = DFF * 2; S.pitchB = DFF * 2; S.nt = DFF / 64;
                S.extra = lastl ? 0 : 8 * 11; S.xn = 8; S.xnt = 8;
                EpiRes E{a->out, a->out, XC, XC, modx + 5 * D, modc + 5 * D, (float*)(ws + OFF_PART)}; pg8::gemm_phase(lds, S, E); }
        }
      }
        if (vp + 1 < ph_hi + (DUP_PH >= 0 ? 1 : 0)) { xcd_barrier(bar); if (DUP_SYNC) xcd_barrier(bar); }
    }
}

extern "C" void kernel_launch(void* const* d_in, const int* in_sizes, int n_in, void* d_out, int out_size, void* d_ws, size_t ws_size, hipStream_t stream) {
    static int grid = 0;
    if (grid == 0) {
        if (n_in != 25 || out_size != L * D || ws_size < WS_END) { fprintf(stderr, "kernel_launch: unexpected shapes (n_in %d out %d ws %zu need %zu)\n", n_in, out_size, ws_size, (size_t)WS_END); grid = -1; return; }
        int dev = 0, cus = 0, per_cu = 0;
        hipGetDevice(&dev); hipDeviceGetAttribute(&cus, hipDeviceAttributeMultiprocessorCount, dev);
        if (hipFuncSetAttribute((const void*)mega, hipFuncAttributeMaxDynamicSharedMemorySize, LDS_BYTES) != hipSuccess) { fprintf(stderr, "kernel_launch: hipFuncSetAttribute failed\n"); grid = -1; return; }
        hipOccupancyMaxActiveBlocksPerMultiprocessor(&per_cu, (const void*)mega, NTHREADS, LDS_BYTES);
        (void)hipGetLastError();
        if (per_cu < 1) per_cu = 1;
        grid = cus * 1;
        if (grid <= 0) grid = 256;
    }
    if (grid < 0) return;
    if (hipMemsetAsync((char*)d_ws + OFF_BAR, 0, BAR_BYTES, stream) != hipSuccess) { fprintf(stderr, "kernel_launch: memset failed\n"); return; }
    Args a{};
    const float** pp = (const float**)&a;
    for (int i = 0; i < 25; ++i) pp[i] = (const float*)d_in[i];
    a.out = (float*)d_out; a.ws = (unsigned char*)d_ws;
#if N_LAUNCH_MODE == 1
    a.ph_lo = 0; a.ph_hi = N_PHASES;
    void* args[] = {&a};
    hipError_t e = hipLaunchCooperativeKernel((const void*)mega, dim3(grid), dim3(NTHREADS), args, LDS_BYTES, stream);
    if (e != hipSuccess) fprintf(stderr, "cooperative launch failed: %s (grid %d)\n", hipGetErrorString(e), grid);
#else
    for (int ph = 0; ph < N_PHASES; ++ph) { a.ph_lo = ph; a.ph_hi = ph + 1; hipLaunchKernelGGL(mega, dim3(grid), dim3(NTHREADS), LDS_BYTES, stream, a); }
#endif
}
```
